# Optimizing an MI355X kernel written in HIP

```python
import math
import jax, jax.numpy as jnp
from jax import lax
import numpy as np

D_MODEL = 1024
BATCH = 2
SEQ = 16384
DEPTH = 2

CHUNK = 64
N_MEM = 256
D_MIX = D_MODEL
POOL_WINDOWS = (2, 4, 8, 16)
POOL_GROUPS = len(POOL_WINDOWS)
POOL_CH = 64
W_A = POOL_GROUPS * POOL_CH
SG_BLOCK = 2 * CHUNK
SG_HEADS = 4
SG_HEAD_DIM = 96
W_B = SG_HEADS * SG_HEAD_DIM
CONV_K = 31
W_C = D_MIX - W_A - W_B
D_IN = W_A + 2 * W_B + 2 * W_C
X_HEADS = 4
X_HEAD_DIM = D_MODEL // X_HEADS
D_FF = 4 * D_MODEL
EPS = 1e-6

kernel_name = "hybrid_pool_sgmlp_conformer_block"


def rms_norm(x, g):
    xf = x.astype(jnp.float32)
    y = xf * lax.rsqrt(jnp.mean(jnp.square(xf), axis=-1, keepdims=True) + EPS)
    return (y * g.astype(jnp.float32)).astype(x.dtype)


def layer_norm(x, g, b):
    xf = x.astype(jnp.float32)
    mu = jnp.mean(xf, axis=-1, keepdims=True)
    var = jnp.mean(jnp.square(xf - mu), axis=-1, keepdims=True)
    y = (xf - mu) * lax.rsqrt(var + EPS)
    return (y * g.astype(jnp.float32) + b.astype(jnp.float32)).astype(x.dtype)


def pool_mixer(a, pool_w, pool_scale):
    bsz, s, _ = a.shape
    ag = a.reshape(bsz, s, POOL_GROUPS, POOL_CH).astype(jnp.float32)
    cs = jnp.cumsum(ag, axis=1)
    pos = jnp.arange(1, s + 1, dtype=jnp.float32)[None, :, None]
    outs = []
    for g, w in enumerate(POOL_WINDOWS):
        c = cs[:, :, g]
        lag = jnp.pad(c[:, : s - w], ((0, 0), (w, 0), (0, 0)))
        cnt = jnp.minimum(pos, float(w))
        outs.append((c - lag) / cnt - ag[:, :, g])
    p = jnp.stack(outs, axis=2).astype(a.dtype)
    y = jnp.einsum('bsgc,gcd->bsgd', p, pool_w)
    return y.reshape(bsz, s, W_A) * pool_scale


def spatial_gating_mixer(z, ln_g, ln_b, sg_w, sg_b):
    bsz, s, _ = z.shape
    z = jax.nn.gelu(z)
    u, v = jnp.split(z, 2, axis=-1)
    v = layer_norm(v, ln_g, ln_b)
    nb = s // SG_BLOCK
    v = v.reshape(bsz, nb, SG_BLOCK, SG_HEADS, SG_HEAD_DIM)
    u = u.reshape(bsz, nb, SG_BLOCK, SG_HEADS, SG_HEAD_DIM)
    mask = jnp.tril(jnp.ones((SG_BLOCK, SG_BLOCK), dtype=sg_w.dtype))
    w = sg_w * mask[None]
    sv = jnp.einsum('hts,bnshd->bnthd', w, v) + jnp.transpose(sg_b)[None, None, :, :, None]
    return (u * sv).reshape(bsz, s, W_B)


def conformer_conv_mixer(z, conv_w, conv_b, ln_g, ln_b):
    a, g = jnp.split(z, 2, axis=-1)
    h = a * jax.nn.sigmoid(g)
    h = lax.conv_general_dilated(
        h, conv_w[:, None, :], window_strides=(1,), padding=[(CONV_K - 1, 0)],
        dimension_numbers=('NWC', 'WIO', 'NWC'), feature_group_count=W_C)
    h = h + conv_b
    h = layer_norm(h, ln_g, ln_b)
    return jax.nn.silu(h)


def memory_cross_attention(h, m, wq, wk, wv, wo):
    bsz, s, _ = h.shape
    q = (h @ wq).reshape(bsz, s, X_HEADS, X_HEAD_DIM)
    k = (m @ wk).reshape(bsz, N_MEM, X_HEADS, X_HEAD_DIM)
    v = (m @ wv).reshape(bsz, N_MEM, X_HEADS, X_HEAD_DIM)
    sc = jnp.einsum('bshd,bmhd->bhsm', q, k).astype(jnp.float32) * (1.0 / math.sqrt(X_HEAD_DIM))
    p = jax.nn.softmax(sc, axis=-1).astype(v.dtype)
    o = jnp.einsum('bhsm,bmhd->bshd', p, v).reshape(bsz, s, D_MODEL)
    return o @ wo


def setup_inputs(seed: int = 0) -> dict:
    key = jax.random.key(seed)
    ks = iter(jax.random.split(key, 40))
    L, D = DEPTH, D_MODEL

    def nrm(shape, scale):
        return jax.random.normal(next(ks), shape, dtype=jnp.float32) * scale

    def gain(shape):
        return 1.0 + nrm(shape, 0.05)

    return {
        "x": nrm((BATCH, SEQ, D), 1.0),
        "mem": nrm((BATCH, N_MEM, D), 1.0),
        "pre_mix_g": gain((L, D)),
        "w_in": nrm((L, D, D_IN), D ** -0.5),
        "b_in": nrm((L, D_IN), 0.02),
        "pool_w": nrm((L, POOL_GROUPS, POOL_CH, POOL_CH), POOL_CH ** -0.5),
        "pool_scale": gain((L, W_A)),
        "sg_ln_g": gain((L, W_B)),
        "sg_ln_b": nrm((L, W_B), 0.02),
        "sg_w": nrm((L, SG_HEADS, SG_BLOCK, SG_BLOCK), SG_BLOCK ** -0.5),
        "sg_b": gain((L, SG_HEADS, SG_BLOCK)),
        "conv_w": nrm((L, CONV_K, W_C), CONV_K ** -0.5),
        "conv_b": nrm((L, W_C), 0.02),
        "conv_ln_g": gain((L, W_C)),
        "conv_ln_b": nrm((L, W_C), 0.02),
        "w_out": nrm((L, D_MIX, D), D_MIX ** -0.5),
        "post_mix_g": gain((L, D)),
        "pre_x_g": gain((L, D)),
        "mem_g": gain((L, D)),
        "wq": nrm((L, D, D), D ** -0.5),
        "wk": nrm((L, D, D), D ** -0.5),
        "wv": nrm((L, D, D), D ** -0.5),
        "wo": nrm((L, D, D), D ** -0.5),
        "post_x_g": gain((L, D)),
        "pre_ff_g": gain((L, D)),
        "w_ff1": nrm((L, D, D_FF), D ** -0.5),
        "w_ff2": nrm((L, D_FF, D), D_FF ** -0.5),
        "post_ff_g": gain((L, D)),
    }


def reference(x, mem, pre_mix_g, w_in, b_in, pool_w, pool_scale, sg_ln_g, sg_ln_b,
              sg_w, sg_b, conv_w, conv_b, conv_ln_g, conv_ln_b, w_out, post_mix_g,
              pre_x_g, mem_g, wq, wk, wv, wo, post_x_g, pre_ff_g, w_ff1, w_ff2,
              post_ff_g):
    for l in range(DEPTH):
        h = rms_norm(x, pre_mix_g[l])
        z = h @ w_in[l] + b_in[l]
        z_a = z[..., :W_A]
        z_b = z[..., W_A:W_A + 2 * W_B]
        z_c = z[..., W_A + 2 * W_B:]
        y_a = pool_mixer(z_a, pool_w[l], pool_scale[l])
        y_b = spatial_gating_mixer(z_b, sg_ln_g[l], sg_ln_b[l], sg_w[l], sg_b[l])
        y_c = conformer_conv_mixer(z_c, conv_w[l], conv_b[l], conv_ln_g[l], conv_ln_b[l])
        y = jnp.concatenate([y_a, y_b, y_c], axis=-1) @ w_out[l]
        x = x + rms_norm(y, post_mix_g[l])
        h = rms_norm(x, pre_x_g[l])
        m = rms_norm(mem, mem_g[l])
        y = memory_cross_attention(h, m, wq[l], wk[l], wv[l], wo[l])
        x = x + rms_norm(y, post_x_g[l])
        h = rms_norm(x, pre_ff_g[l])
        y = jnp.square(jax.nn.relu(h @ w_ff1[l])) @ w_ff2[l]
        x = x + rms_norm(y, post_ff_g[l])
    return x
```

```cpp
#include <hip/hip_runtime.h>
#include <hip/hip_cooperative_groups.h>
#include <cstdio>
#include <cstdint>
namespace cg = cooperative_groups;
namespace pg8 {
#define PG8_LAS __attribute__((address_space(3)))
typedef unsigned short bf16_t;
typedef short bf16x8 __attribute__((ext_vector_type(8)));
typedef float f32x4 __attribute__((ext_vector_type(4)));
typedef unsigned u32x4 __attribute__((ext_vector_type(4)));
constexpr int BM = 256, BK = 64, HALF = 128, HTB = HALF * BK * 2  , STAGE_BYTES = 8 * HTB, NXCD = 8, WGM = 8;

__host__ __device__ __forceinline__ int lds_byte(int r, int c) { const int st = (r >> 4) * 2 + (c >> 5), rr = r & 15, cc = c & 31, ob = rr * 64 + cc * 2; return st * 1024 + (ob ^ (((ob >> 9) & 1) << 5)); }
__host__ __device__ __forceinline__ void stage_rc(int b, int& R, int& C) { const int st = b / 1024, sb = b % 1024, swz = sb ^ (((sb >> 9) & 1) << 5); R = (st >> 1) * 16 + swz / 64; C = (st & 1) * 32 + (swz % 64) / 2; }
__host__ __device__ __forceinline__ int perm32(int rho) { const int n = rho >> 4, i = rho & 15; return 8 * (i >> 2) + 4 * n + (i & 3); }

struct Unit { int pm, pn; };
struct Gemm { const bf16_t* A; const bf16_t* Bt; int M, N, K; };

struct StaticOrder {
    int nM, nN, nwg, G, c;
    __host__ __device__ void init(int M, int N, int G_, int c_) { nM = M / BM; nN = N / BM; nwg = nM * nN; G = G_; c = c_; }
    __host__ __device__ bool next(int i, Unit& u) const {
        const long L = (long)i * G + c; if (L >= nwg) return false;
        int wgid = (int)L; { const int q = nwg / NXCD, r = nwg % NXCD, xcd = wgid % NXCD, off = wgid / NXCD; wgid = (xcd < r ? xcd * (q + 1) : r * (q + 1) + (xcd - r) * q) + off; }
        const int nig = WGM * nN, gid = wgid / nig, fm = gid * WGM, gsz = (nM - fm) < WGM ? (nM - fm) : WGM;
        u.pm = fm + ((wgid % nig) % gsz); u.pn = (wgid % nig) / gsz; return true;
    }
    __device__ __forceinline__ void a_ready(const Unit&) const {}
    __device__ __forceinline__ void done(const Unit&) const {}
};

__device__ __forceinline__ unsigned cvt_pk_bf16(float lo, float hi) { unsigned r; asm volatile("v_cvt_pk_bf16_f32 %0, %1, %2" : "=v"(r) : "v"(lo), "v"(hi)); return r; }
typedef float f32x2 __attribute__((ext_vector_type(2)));
__device__ __forceinline__ f32x2 gelu_pk(f32x2 v) {
    const f32x2 av = __builtin_elementwise_abs(v), d = av * 0.2316418882f + 1.0f;
    f32x2 t; t.x = __builtin_amdgcn_rcpf(d.x); t.y = __builtin_amdgcn_rcpf(d.y);
    f32x2 q = t * 0.5307027145f + (-0.7265760135f); q = q * t + 0.7107068705f; q = q * t + (-0.142248368f); q = q * t + 0.127414796f; q = q * t;
    const f32x2 s = (v * v) * (-0.72134752044f);
    f32x2 e; e.x = __builtin_amdgcn_exp2f(s.x); e.y = __builtin_amdgcn_exp2f(s.y);
    const f32x2 m = v * (q * e), r = v - m;
    f32x2 o; o.x = v.x < 0.f ? m.x : r.x; o.y = v.y < 0.f ? m.y : r.y; return o;
}

template <int ACT  > struct EpiBf16 {
    static constexpr bool PERM = true, AFTER_DRAIN = false; static_assert(ACT == 0 || ACT == 1, "EpiBf16: ACT is 0 (none) or 1 (gelu_pk)");
    bf16_t* O; int ldc; const float* bias; int split_cols; size_t split_stride; float scale0;
    __device__ __forceinline__ void operator()(const f32x4 (&acc)[2][2][4][2], const Unit& u, int wr, int wc, int fr, int fq) const {
        const int row0 = u.pm * BM + wr * 64 + fr; int colt = u.pn * BM; bf16_t* base = O;
        float sc = 1.f; if (split_cols) { const int t = colt / split_cols; base += (size_t)t * split_stride; colt -= t * split_cols; if (t == 0) sc = scale0; }
        const int col0 = colt + wc * 32 + 8 * fq, bcol0 = u.pn * BM + wc * 32 + 8 * fq;
        f32x4 bv[2][2];
#pragma unroll
        for (int bj = 0; bj < 2; ++bj)
#pragma unroll
            for (int n = 0; n < 2; ++n) bv[bj][n] = bias ? *(const f32x4*)(bias + bcol0 + bj * HALF + 4 * n) : (f32x4){0.f, 0.f, 0.f, 0.f};
#pragma unroll
        for (int ai = 0; ai < 2; ++ai)
#pragma unroll
            for (int m = 0; m < 4; ++m) { bf16_t* rowp = base + (size_t)(row0 + ai * HALF + m * 16) * ldc + col0;
#pragma unroll
                for (int bj = 0; bj < 2; ++bj) { f32x4 v0 = acc[ai][bj][m][0] + bv[bj][0], v1 = acc[ai][bj][m][1] + bv[bj][1];
                    if (ACT == 1) { f32x2 a = gelu_pk((f32x2){v0[0], v0[1]}), b = gelu_pk((f32x2){v0[2], v0[3]}), c = gelu_pk((f32x2){v1[0], v1[1]}), d = gelu_pk((f32x2){v1[2], v1[3]});
                        v0 = (f32x4){a.x, a.y, b.x, b.y}; v1 = (f32x4){c.x, c.y, d.x, d.y}; }
                    v0 = v0 * sc; v1 = v1 * sc; u32x4 w; w.x = cvt_pk_bf16(v0[0], v0[1]); w.y = cvt_pk_bf16(v0[2], v0[3]); w.z = cvt_pk_bf16(v1[0], v1[1]); w.w = cvt_pk_bf16(v1[2], v1[3]);
                    *(u32x4*)(rowp + bj * HALF) = w; } }
    }
};


struct EpiGen {
    static constexpr bool PERM = true, AFTER_DRAIN = false;
    bf16_t* O; int ldc; const float* bias; float scale; int act;
    __device__ __forceinline__ void operator()(const f32x4 (&acc)[2][2][4][2], const Unit& u, int wr, int wc, int fr, int fq) const {
        const int row0 = u.pm * BM + wr * 64 + fr;
        const int col0 = u.pn * BM + wc * 32 + 8 * fq;
        f32x4 bv[2][2];
#pragma unroll
        for (int bj = 0; bj < 2; ++bj)
#pragma unroll
            for (int n = 0; n < 2; ++n) bv[bj][n] = bias ? *(const f32x4*)(bias + col0 + bj * HALF + 4 * n) : (f32x4){0.f, 0.f, 0.f, 0.f};
        const float sc = scale;
#pragma unroll
        for (int ai = 0; ai < 2; ++ai)
#pragma unroll
            for (int m = 0; m < 4; ++m) { bf16_t* rowp = O + (size_t)(row0 + ai * HALF + m * 16) * ldc + col0;
#pragma unroll
                for (int bj = 0; bj < 2; ++bj) { f32x4 v0 = acc[ai][bj][m][0] + bv[bj][0], v1 = acc[ai][bj][m][1] + bv[bj][1];
                    if (act) {
#pragma unroll
                        for (int e = 0; e < 4; ++e) { const float a0 = fmaxf(v0[e], 0.f), a1 = fmaxf(v1[e], 0.f); v0[e] = a0 * a0; v1[e] = a1 * a1; }
                    }
                    v0 = v0 * sc; v1 = v1 * sc; u32x4 w; w.x = cvt_pk_bf16(v0[0], v0[1]); w.y = cvt_pk_bf16(v0[2], v0[3]); w.z = cvt_pk_bf16(v1[0], v1[1]); w.w = cvt_pk_bf16(v1[2], v1[3]);
                    *(u32x4*)(rowp + bj * HALF) = w; } }
    }
};

template <class Epi, class Sched, bool ALIGN_EPI = false, bool SP2 = false>
__device__ __forceinline__ void gemm_phase(PG8_LAS unsigned char* lds, const Gemm g, const Sched& S, const Epi& E) {
    const int tid = threadIdx.x, wid = __builtin_amdgcn_readfirstlane(tid >> 6), lane = tid & 63, wr = wid >> 2, wc = wid & 3, fr = lane & 15, fq = lane >> 4;
    const int K = g.K, nt = K / BK;
    unsigned voffA[2], voffB[2];
#pragma unroll
    for (int i = 0; i < 2; ++i) { int R, C; stage_rc(tid * 16 + i * 8192, R, C); const int Rb = Epi::PERM ? ((R & ~31) + perm32(R & 31)) : R;
        voffA[i] = (unsigned)(R * K + C) * 2u; voffB[i] = (unsigned)(Rb * K + C) * 2u; }
    const size_t kstep = (size_t)(BK * 2);
    const size_t hstep = (size_t)HALF * K * 2;
    const size_t tstep = 2 * hstep;
    const unsigned ldsw = (unsigned)wid * 1024u;
    const int aoff = lds_byte(wr * 64 + fr, fq * 8), boff = lds_byte(wc * 32 + fr, fq * 8);
#define PG8_SA(b, h) (((b) * 2 + (h)) * HTB)
#define PG8_SB(b, h) ((4 + (b) * 2 + (h)) * HTB)
#define PG8_STAGE(bufoff, gbase, voff) do { _Pragma("unroll") for (int _i = 0; _i < 2; ++_i) \
        __builtin_amdgcn_global_load_lds((const unsigned*)((const char*)(gbase) + (voff)[_i]), (PG8_LAS unsigned*)(lds + (bufoff) + ldsw + _i * 8192), 16, 0, 0); } while (0)
#define PG8_LDA(dst, b, h) do { _Pragma("unroll") for (int m = 0; m < 4; ++m) _Pragma("unroll") for (int k = 0; k < 2; ++k) dst[m][k] = *(const PG8_LAS bf16x8*)(lds + PG8_SA(b, h) + aoff + m * 2048 + k * 1024); } while (0)
#define PG8_LDB(dst, b, h) do { _Pragma("unroll") for (int n = 0; n < 2; ++n) _Pragma("unroll") for (int k = 0; k < 2; ++k) dst[n][k] = *(const PG8_LAS bf16x8*)(lds + PG8_SB(b, h) + boff + n * 2048 + k * 1024); } while (0)
#define PG8_MMA(ai, bj, At, Bt) do { __builtin_amdgcn_s_setprio(1); _Pragma("unroll") for (int m = 0; m < 4; ++m) _Pragma("unroll") for (int n = 0; n < 2; ++n) _Pragma("unroll") for (int k = 0; k < 2; ++k) \
        acc[ai][bj][m][n] = __builtin_amdgcn_mfma_f32_16x16x32_bf16(Bt[n][k], At[m][k], acc[ai][bj][m][n], 0, 0, 0); __builtin_amdgcn_s_setprio(0); } while (0)
#define PG8_WAIT_V(n) asm volatile("s_waitcnt vmcnt(" #n ")" ::: "memory")
#define PG8_WAIT_L(n) asm volatile("s_waitcnt lgkmcnt(" #n ")" ::: "memory")
#define PG8_BAR __builtin_amdgcn_s_barrier()
#define PG8_SCHED __builtin_amdgcn_sched_barrier(0)
    Unit cur, nxt; int ui = 0;
    if (!S.next(0, cur)) return;
    f32x4 acc[2][2][4][2];
#pragma unroll
    for (int a = 0; a < 2; ++a)
#pragma unroll
        for (int b = 0; b < 2; ++b)
#pragma unroll
            for (int m = 0; m < 4; ++m)
#pragma unroll
                for (int n = 0; n < 2; ++n) acc[a][b][m][n] = (f32x4){0.f, 0.f, 0.f, 0.f};
    bf16x8 At[4][2], B0[2][2], B1[2][2];
    const char* cA = (const char*)g.A + (size_t)cur.pm * tstep; const char* cB = (const char*)g.Bt + (size_t)cur.pn * tstep;
    S.a_ready(cur);
    if constexpr (SP2) {
        PG8_STAGE(PG8_SB(0, 0), cB, voffB); PG8_STAGE(PG8_SB(0, 1), cB + hstep, voffB); PG8_STAGE(PG8_SA(0, 0), cA, voffA); PG8_STAGE(PG8_SA(0, 1), cA + hstep, voffA);
        if (wr == 1) PG8_BAR;
        PG8_WAIT_V(2); PG8_BAR;
        PG8_STAGE(PG8_SB(1, 0), cB + kstep, voffB); PG8_STAGE(PG8_SA(1, 0), cA + kstep, voffA); PG8_STAGE(PG8_SB(1, 1), cB + hstep + kstep, voffB);
        PG8_WAIT_V(6); PG8_BAR;
    } else {
        PG8_STAGE(PG8_SB(0, 0), cB, voffB); PG8_STAGE(PG8_SA(0, 0), cA, voffA); PG8_STAGE(PG8_SB(0, 1), cB + hstep, voffB); PG8_STAGE(PG8_SA(0, 1), cA + hstep, voffA);
        if (wr == 1) PG8_BAR;
        PG8_WAIT_V(4); PG8_BAR;
        PG8_STAGE(PG8_SB(1, 0), cB + kstep, voffB); PG8_STAGE(PG8_SA(1, 0), cA + kstep, voffA); PG8_STAGE(PG8_SB(1, 1), cB + hstep + kstep, voffB);
        PG8_WAIT_V(6); PG8_BAR;
    }
    for (;;) {
        const bool has_next = S.next(ui + 1, nxt);
        const char* nA = has_next ? (const char*)g.A + (size_t)nxt.pm * tstep : cA; const char* nB = has_next ? (const char*)g.Bt + (size_t)nxt.pn * tstep : cB;
        for (int t = 0; t < nt; t += 2) {
            const bool last = (t == nt - 2);
            const char* a1 = cA + (size_t)(t + 1) * kstep;
            const char* a2 = last ? nA : cA + (size_t)(t + 2) * kstep; const char* b2 = last ? nB : cB + (size_t)(t + 2) * kstep;
            const char* a3 = a2 + kstep; const char* b3 = b2 + kstep;
            if (last && has_next) S.a_ready(nxt);
            if constexpr (SP2) {
            PG8_LDB(B0, 0, 0); PG8_LDB(B1, 0, 1); PG8_SCHED; PG8_LDA(At, 0, 0); PG8_STAGE(PG8_SA(1, 1), a1 + hstep, voffA);
            PG8_WAIT_V(8); PG8_WAIT_L(0); PG8_BAR; PG8_MMA(0, 0, At, B0); PG8_MMA(0, 1, At, B1); PG8_BAR; PG8_SCHED;
            PG8_LDA(At, 0, 1); PG8_STAGE(PG8_SB(0, 0), b2, voffB); PG8_STAGE(PG8_SB(0, 1), b2 + hstep, voffB); PG8_STAGE(PG8_SA(0, 0), a2, voffA);
            PG8_WAIT_V(8); PG8_WAIT_L(0); PG8_BAR; PG8_MMA(1, 0, At, B0); PG8_MMA(1, 1, At, B1); PG8_BAR; PG8_SCHED;
            PG8_LDB(B0, 1, 0); PG8_LDB(B1, 1, 1); PG8_SCHED; PG8_LDA(At, 1, 0); PG8_STAGE(PG8_SA(0, 1), a2 + hstep, voffA);
            PG8_WAIT_V(8); PG8_WAIT_L(0); PG8_BAR; PG8_MMA(0, 0, At, B0); PG8_MMA(0, 1, At, B1); PG8_BAR; PG8_SCHED;
            PG8_LDA(At, 1, 1); PG8_STAGE(PG8_SB(1, 0), b3, voffB); PG8_STAGE(PG8_SB(1, 1), b3 + hstep, voffB); PG8_STAGE(PG8_SA(1, 0), a3, voffA);
            PG8_WAIT_V(8); PG8_WAIT_L(0); PG8_BAR; PG8_MMA(1, 0, At, B0); PG8_MMA(1, 1, At, B1); PG8_BAR; PG8_SCHED;
            } else {
            PG8_LDB(B0, 0, 0); PG8_SCHED; PG8_LDA(At, 0, 0); PG8_STAGE(PG8_SA(1, 1), a1 + hstep, voffA);
            PG8_WAIT_L(8); PG8_BAR; PG8_WAIT_L(0); PG8_MMA(0, 0, At, B0); PG8_BAR; PG8_SCHED;
            PG8_LDB(B1, 0, 1); PG8_STAGE(PG8_SB(0, 0), b2, voffB);
            PG8_BAR; PG8_WAIT_L(0); PG8_MMA(0, 1, At, B1); PG8_BAR;
            PG8_LDA(At, 0, 1); PG8_STAGE(PG8_SA(0, 0), a2, voffA);
            PG8_BAR; PG8_WAIT_L(0); PG8_MMA(1, 0, At, B0); PG8_BAR; PG8_SCHED;
            PG8_STAGE(PG8_SB(0, 1), b2 + hstep, voffB);
            PG8_WAIT_V(6); PG8_BAR; PG8_MMA(1, 1, At, B1); PG8_BAR;
            PG8_LDB(B0, 1, 0); PG8_SCHED; PG8_LDA(At, 1, 0); PG8_STAGE(PG8_SA(0, 1), a2 + hstep, voffA);
            PG8_WAIT_L(8); PG8_BAR; PG8_WAIT_L(0); PG8_MMA(0, 0, At, B0); PG8_BAR; PG8_SCHED;
            PG8_LDB(B1, 1, 1); PG8_STAGE(PG8_SB(1, 0), b3, voffB);
            PG8_BAR; PG8_WAIT_L(0); PG8_MMA(0, 1, At, B1); PG8_BAR;
            PG8_LDA(At, 1, 1); PG8_STAGE(PG8_SA(1, 0), a3, voffA);
            PG8_BAR; PG8_WAIT_L(0); PG8_MMA(1, 0, At, B0); PG8_BAR; PG8_SCHED;
            PG8_STAGE(PG8_SB(1, 1), b3 + hstep, voffB);
            PG8_WAIT_V(6); PG8_BAR; PG8_MMA(1, 1, At, B1); PG8_BAR;
            }
        }
        if constexpr (ALIGN_EPI) { if (wr == 0) PG8_BAR; }
        if constexpr (!Epi::AFTER_DRAIN) { E(acc, cur, wr, wc, fr, fq); S.done(cur); }
        if (!has_next) break;
#pragma unroll
        for (int a = 0; a < 2; ++a)
#pragma unroll
            for (int b = 0; b < 2; ++b)
#pragma unroll
                for (int m = 0; m < 4; ++m)
#pragma unroll
                    for (int n = 0; n < 2; ++n) acc[a][b][m][n] = (f32x4){0.f, 0.f, 0.f, 0.f};
        cur = nxt; cA = nA; cB = nB; ++ui;
        if constexpr (ALIGN_EPI) { if (wr == 1) PG8_BAR; }
    }
    PG8_WAIT_V(0);
    if constexpr (!ALIGN_EPI) { if (wr == 0) PG8_BAR; }
    PG8_BAR;
    if constexpr (Epi::AFTER_DRAIN) { E.fused(acc, cur, wr, wc, fr, fq, lds, wid, lane); S.done(cur); }
#undef PG8_SA
#undef PG8_SB
#undef PG8_STAGE
#undef PG8_LDA
#undef PG8_LDB
#undef PG8_MMA
#undef PG8_WAIT_V
#undef PG8_WAIT_L
#undef PG8_BAR
#undef PG8_SCHED
}
}

#ifndef MK_N_LAUNCHES
#define MK_N_LAUNCHES 24
#endif
constexpr int BATCH = 2, SEQ = 16384, D = 1024, M = BATCH * SEQ, DEPTH = 2;
constexpr int NMEM = 256, MMEM = BATCH * NMEM;
constexpr int W_A = 256, W_B = 384, W_C = 384, D_IN = 1792, FF = 4096, CONV_K = 31;
constexpr int ZB_OFF = W_A, ZV_OFF = W_A + W_B, ZC_OFF = W_A + 2 * W_B, ZG_OFF = ZC_OFF + W_C;
constexpr float EPS = 1e-6f;
constexpr int NWAVES = 8, NTHREADS = 512;
constexpr int LDS_BYTES = 147456;
constexpr int NPH = 2 + 11 * DEPTH;

constexpr size_t MiB = 1u << 20;
constexpr size_t WS_W = 2 * MiB, WS_WL = 30 * MiB;
constexpr size_t WO_IN = 0, WO_OUT = 4 * MiB, WO_Q = 6 * MiB, WO_K = 8 * MiB, WO_V = 10 * MiB, WO_O = 12 * MiB, WO_1 = 14 * MiB, WO_2 = 22 * MiB;
constexpr size_t WS_SGW = 62 * MiB;
constexpr size_t WS_MN = 63 * MiB, WS_KB = 65 * MiB, WS_VT = 67 * MiB;
constexpr size_t WS_XN = 70 * MiB, WS_Y = 134 * MiB, WS_Z = 198 * MiB, WS_BUFA = 310 * MiB, WS_F = 198 * MiB, WS_END = 454 * MiB;

typedef unsigned short bf16;
typedef short bf16x8 __attribute__((ext_vector_type(8)));
typedef float f32x4 __attribute__((ext_vector_type(4)));
typedef float f32x16 __attribute__((ext_vector_type(16)));
typedef unsigned u32x4 __attribute__((ext_vector_type(4)));
typedef unsigned u32x2 __attribute__((ext_vector_type(2)));
#define LAS __attribute__((address_space(3)))
#define LDS_WAIT() asm volatile("s_waitcnt lgkmcnt(0)" ::: "memory")

__device__ __forceinline__ float bf2f(unsigned v) { return __uint_as_float(v << 16); }
__device__ __forceinline__ float bflo(unsigned w) { return __uint_as_float(w << 16); }
__device__ __forceinline__ float bfhi(unsigned w) { return __uint_as_float(w & 0xffff0000u); }
__device__ __forceinline__ unsigned pk2(float lo, float hi) { return pg8::cvt_pk_bf16(lo, hi); }
__device__ __forceinline__ float wave_sum(float v) {
#pragma unroll
    for (int o = 1; o < 64; o <<= 1) v += __shfl_xor(v, o);
    return v;
}
__device__ __forceinline__ float sigmoidf_(float x) { return 1.0f / (1.0f + __expf(-x)); }
__device__ __forceinline__ float gelu_tanh(float x) { const float u = 1.5957691216f * (x + 0.044715f * x * x * x); return x / (1.0f + __expf(-u)); }

struct Args { const float* in[28]; float* out; unsigned char* ws; int ph_lo, ph_hi; };

__device__ __forceinline__ void p0_transpose_item(const float* W, int K, int N, bf16* WT, LAS float* scr, int item, int lane) {
    const int nblk = N / 32, kb = item / nblk, nb = item % nblk, k0 = 64 * kb, n0 = 32 * nb;
#pragma unroll 8
    for (int i = 0; i < 32; ++i) { const int kk = 2 * i + (lane >> 5); scr[kk * 33 + (lane & 31)] = W[(size_t)(k0 + kk) * N + n0 + (lane & 31)]; }
    LDS_WAIT(); asm volatile("" ::: "memory");
    const int c = lane & 7;
#pragma unroll
    for (int j = 0; j < 4; ++j) { const int n = (lane >> 3) + 8 * j; const LAS float* s = scr + (8 * c) * 33 + n;
        u32x4 o; o.x = pk2(s[0 * 33], s[1 * 33]); o.y = pk2(s[2 * 33], s[3 * 33]); o.z = pk2(s[4 * 33], s[5 * 33]); o.w = pk2(s[6 * 33], s[7 * 33]);
        *(u32x4*)(WT + (size_t)(n0 + n) * K + k0 + 8 * c) = o; }
    LDS_WAIT(); asm volatile("" ::: "memory");
}
__device__ __forceinline__ void rms_row_to_bf16(const float* xrow, const float* g, bf16* orow, int lane) {
    const f32x4* xr = (const f32x4*)xrow + lane; const f32x4* gr = (const f32x4*)g + lane;
    f32x4 v[4]; float s = 0.f;
#pragma unroll
    for (int j = 0; j < 4; ++j) { v[j] = xr[64 * j]; s += (v[j].x * v[j].x + v[j].y * v[j].y) + (v[j].z * v[j].z + v[j].w * v[j].w); }
    const float r = 1.0f / sqrtf(wave_sum(s) * (1.f / D) + EPS);
    u32x2* o8 = (u32x2*)orow + lane;
#pragma unroll
    for (int j = 0; j < 4; ++j) { const f32x4 gg = gr[64 * j]; u32x2 w; w.x = pk2(v[j].x * r * gg.x, v[j].y * r * gg.y); w.y = pk2(v[j].z * r * gg.z, v[j].w * r * gg.w); o8[64 * j] = w; }
}

__device__ __forceinline__ void p0_prologue(const Args& a, LAS unsigned char* lds, int gw, int NGW, int wave, int lane) {
    LAS float* scr = (LAS float*)(lds + wave * 16384);
    constexpr int I_IN = (D / 64) * (D_IN / 32), I_SQ = (D / 64) * (D / 32), I_1 = (D / 64) * (FF / 32), I_2 = (FF / 64) * (D / 32);
    constexpr int I_L = I_IN + 5 * I_SQ + I_1 + I_2;
    for (int it = gw; it < DEPTH * I_L; it += NGW) {
        const int l = it / I_L; int r = it % I_L;
        unsigned char* wb = a.ws + WS_W + (size_t)l * WS_WL;
        if (r < I_IN) { p0_transpose_item(a.in[3] + (size_t)l * D * D_IN, D, D_IN, (bf16*)(wb + WO_IN), scr, r, lane); continue; } r -= I_IN;
        if (r < I_SQ) { p0_transpose_item(a.in[15] + (size_t)l * D * D, D, D, (bf16*)(wb + WO_OUT), scr, r, lane); continue; } r -= I_SQ;
        if (r < I_SQ) { p0_transpose_item(a.in[19] + (size_t)l * D * D, D, D, (bf16*)(wb + WO_Q), scr, r, lane); continue; } r -= I_SQ;
        if (r < I_SQ) { p0_transpose_item(a.in[20] + (size_t)l * D * D, D, D, (bf16*)(wb + WO_K), scr, r, lane); continue; } r -= I_SQ;
        if (r < I_SQ) { p0_transpose_item(a.in[21] + (size_t)l * D * D, D, D, (bf16*)(wb + WO_V), scr, r, lane); continue; } r -= I_SQ;
        if (r < I_SQ) { p0_transpose_item(a.in[22] + (size_t)l * D * D, D, D, (bf16*)(wb + WO_O), scr, r, lane); continue; } r -= I_SQ;
        if (r < I_1) { p0_transpose_item(a.in[25] + (size_t)l * D * FF, D, FF, (bf16*)(wb + WO_1), scr, r, lane); continue; } r -= I_1;
        p0_transpose_item(a.in[26] + (size_t)l * FF * D, FF, D, (bf16*)(wb + WO_2), scr, r, lane);
    }
    for (int m = gw; m < M + DEPTH * MMEM; m += NGW) {
        if (m < M) rms_row_to_bf16(a.in[0] + (size_t)m * D, a.in[2], (bf16*)(a.ws + WS_XN) + (size_t)m * D, lane);
        else { const int mm = m - M, l = mm / MMEM, r = mm % MMEM;
            rms_row_to_bf16(a.in[1] + (size_t)r * D, a.in[18] + (size_t)l * D, (bf16*)(a.ws + WS_MN + (size_t)l * MiB) + (size_t)r * D, lane); }
    }
    { const int gt = gw * 64 + lane, NGT = NGW * 64;
      for (int i = gt; i < DEPTH * 4 * 128 * 128 / 8; i += NGT) {
          const int e0 = i * 8, s0 = e0 & 127, t = (e0 >> 7) & 127;
          const f32x4 a0 = *(const f32x4*)(a.in[9] + e0), a1 = *(const f32x4*)(a.in[9] + e0 + 4);
          float v[8] = {a0.x, a0.y, a0.z, a0.w, a1.x, a1.y, a1.z, a1.w};
#pragma unroll
          for (int e = 0; e < 8; ++e) v[e] = (s0 + e <= t) ? v[e] : 0.f;
          u32x4 o; o.x = pk2(v[0], v[1]); o.y = pk2(v[2], v[3]); o.z = pk2(v[4], v[5]); o.w = pk2(v[6], v[7]);
          *(u32x4*)((bf16*)(a.ws + WS_SGW) + e0) = o; } }
}

__device__ __forceinline__ void resnorm_phase(const float* xsrc, const bf16* Y, float* xdst, bf16* XN, const float* g1, const float* g2, int gw, int NGW, int lane) {
    for (int m = gw; m < M; m += NGW) {
        const f32x4* xr = (const f32x4*)(xsrc + (size_t)m * D) + lane;
        const u32x2* yr = (const u32x2*)(Y + (size_t)m * D) + lane;
        f32x4 xv[4], yv[4]; float ss = 0.f;
#pragma unroll
        for (int j = 0; j < 4; ++j) { const u32x2 w = yr[64 * j]; yv[j] = (f32x4){bflo(w.x), bfhi(w.x), bflo(w.y), bfhi(w.y)};
            ss += (yv[j].x * yv[j].x + yv[j].y * yv[j].y) + (yv[j].z * yv[j].z + yv[j].w * yv[j].w); }
#pragma unroll
        for (int j = 0; j < 4; ++j) xv[j] = xr[64 * j];
        const float r1 = 1.0f / sqrtf(wave_sum(ss) * (1.f / D) + EPS);
        float s2 = 0.f;
        f32x4* xo = (f32x4*)(xdst + (size_t)m * D) + lane;
#pragma unroll
        for (int j = 0; j < 4; ++j) { const f32x4 gg = ((const f32x4*)g1)[lane + 64 * j]; xv[j] = xv[j] + yv[j] * r1 * gg;
            s2 += (xv[j].x * xv[j].x + xv[j].y * xv[j].y) + (xv[j].z * xv[j].z + xv[j].w * xv[j].w); xo[64 * j] = xv[j]; }
        if (g2) {
            const float r2 = 1.0f / sqrtf(wave_sum(s2) * (1.f / D) + EPS);
            u32x2* o8 = (u32x2*)(XN + (size_t)m * D) + lane;
#pragma unroll
            for (int j = 0; j < 4; ++j) { const f32x4 gg = ((const f32x4*)g2)[lane + 64 * j]; u32x2 w;
                w.x = pk2(xv[j].x * r2 * gg.x, xv[j].y * r2 * gg.y); w.y = pk2(xv[j].z * r2 * gg.z, xv[j].w * r2 * gg.w); o8[64 * j] = w; }
        }
    }
}

struct MixP { const bf16* Z; bf16* YC; const float *pool_w, *pool_scale, *sg_ln_g, *sg_ln_b, *sg_b, *conv_w, *conv_b, *conv_ln_g, *conv_ln_b; const bf16* SGW; };

constexpr int MX_H = 0, MX_PWT = 0, MX_P = 36864, MX_VT = 0;
constexpr int PWT_LD = 72, P_LD = 264, VT_LD = 136;

__device__ __forceinline__ void mixer_unit(LAS unsigned char* lds, const MixP& p, int unit, int tid, int wave, int lane) {
    const int t0 = unit * 128, s0 = t0 % SEQ;
    const bf16* Zb = p.Z + (size_t)t0 * D_IN;
    bf16* Yb = p.YC + (size_t)t0 * D;
#ifndef SKIP_CONV
    {
        typedef float f32x2 __attribute__((ext_vector_type(2)));
        LAS bf16* H = (LAS bf16*)(lds + MX_H);
        for (int idx = tid; idx < 158 * 48; idx += NTHREADS) {
            const int r = idx / 48, vv = idx % 48, srel = r - 30;
            u32x4 o = {0u, 0u, 0u, 0u};
            if (s0 + srel >= 0) {
                const bf16* zr = Zb + (ptrdiff_t)srel * D_IN + ZC_OFF + 8 * vv;
                const u32x4 av = *(const u32x4*)zr, gv = *(const u32x4*)(zr + W_C);
                o.x = pk2(bflo(av.x) * sigmoidf_(bflo(gv.x)), bfhi(av.x) * sigmoidf_(bfhi(gv.x)));
                o.y = pk2(bflo(av.y) * sigmoidf_(bflo(gv.y)), bfhi(av.y) * sigmoidf_(bfhi(gv.y)));
                o.z = pk2(bflo(av.z) * sigmoidf_(bflo(gv.z)), bfhi(av.z) * sigmoidf_(bfhi(gv.z)));
                o.w = pk2(bflo(av.w) * sigmoidf_(bflo(gv.w)), bfhi(av.w) * sigmoidf_(bfhi(gv.w)));
            }
            *(LAS u32x4*)(H + r * W_C + 8 * vv) = o;
        }
        __syncthreads();
#pragma unroll 1
        for (int tb = 0; tb < 2; ++tb) {
            const int tok0 = wave * 16 + tb * 8;
            int ln = lane; asm volatile("" : "+v"(ln));
            f32x2 acc[3][8];
#pragma unroll
            for (int ch = 0; ch < 3; ++ch) {
                const int c = ch * 128 + 2 * ln;
                f32x2 w[CONV_K];
#pragma unroll
                for (int k = 0; k < CONV_K; ++k) w[k] = *(const f32x2*)(p.conv_w + k * W_C + c);
                const f32x2 cb = *(const f32x2*)(p.conv_b + c);
#pragma unroll
                for (int j = 0; j < 8; ++j) acc[ch][j] = cb;
                const LAS bf16* hp = H + tok0 * W_C + c;
#pragma unroll
                for (int q = 0; q < 38; ++q) {
                    const unsigned hw = *(const LAS unsigned*)(hp + q * W_C);
                    const f32x2 h2 = {bflo(hw), bfhi(hw)};
#pragma unroll
                    for (int j = 0; j < 8; ++j) { if (q - j >= 0 && q - j < CONV_K) acc[ch][j] = acc[ch][j] + h2 * w[q - j]; }
                }
                asm volatile("" ::: "memory");
            }
            float v[16];
#pragma unroll
            for (int j = 0; j < 8; ++j) {
                float s1 = 0.f, s2 = 0.f;
#pragma unroll
                for (int ch = 0; ch < 3; ++ch) { s1 += acc[ch][j].x + acc[ch][j].y; s2 += acc[ch][j].x * acc[ch][j].x + acc[ch][j].y * acc[ch][j].y; }
                v[j] = s1; v[8 + j] = s2;
            }
#pragma unroll
            for (int step = 0; step < 4; ++step) {
                const int half = 8 >> step, mask = 32 >> step;
                const bool b = (lane & mask) != 0;
#pragma unroll
                for (int jj = 0; jj < half; ++jj) {
                    const float send = b ? v[jj] : v[half + jj], keep = b ? v[half + jj] : v[jj];
                    v[jj] = keep + __shfl_xor(send, mask);
                }
            }
            float vt = v[0] + __shfl_xor(v[0], 2);
            vt += __shfl_xor(vt, 1);
#pragma unroll
            for (int j = 0; j < 8; ++j) {
                const float S1 = __int_as_float(__builtin_amdgcn_readlane(__float_as_int(vt), 4 * j));
                const float S2 = __int_as_float(__builtin_amdgcn_readlane(__float_as_int(vt), 32 + 4 * j));
                const float mean = S1 * (1.f / W_C);
                const float var = S2 * (1.f / W_C) - mean * mean;
                const float rstd = 1.0f / sqrtf(fmaxf(var, 0.f) + EPS);
                bf16* yr = Yb + (size_t)(tok0 + j) * D + W_A + W_B;
#pragma unroll
                for (int ch = 0; ch < 3; ++ch) {
                    const int c = ch * 128 + 2 * ln;
                    const f32x2 lg = *(const f32x2*)(p.conv_ln_g + c), lb = *(const f32x2*)(p.conv_ln_b + c);
                    const float y0 = (acc[ch][j].x - mean) * rstd * lg.x + lb.x, y1 = (acc[ch][j].y - mean) * rstd * lg.y + lb.y;
                    *(unsigned*)(yr + c) = pk2(y0 * sigmoidf_(y0), y1 * sigmoidf_(y1));
                }
            }
        }
        __syncthreads();
    }
#endif
#ifndef SKIP_POOL
    {
        LAS bf16* PWt = (LAS bf16*)(lds + MX_PWT);
        LAS bf16* P = (LAS bf16*)(lds + MX_P);
#pragma unroll 4
        for (int i = 0; i < 32; ++i) { const int idx = i * NTHREADS + tid, g = idx >> 12, c = (idx >> 6) & 63, d = idx & 63;
            PWt[(g * 64 + d) * PWT_LD + c] = (bf16)(pk2(p.pool_w[idx], 0.f) & 0xffffu); }
        {
            const int ch = tid & 255, th = tid >> 8, g = ch >> 6, w = 2 << g, tstart = th * 64;
            const bf16* zc = Zb + ch;
            float win = 0.f;
            for (int jj = 1; jj < w; ++jj) { const int srel = tstart - jj; if (s0 + srel >= 0) win += bf2f(zc[(ptrdiff_t)srel * D_IN]); }
#pragma unroll 8
            for (int t = tstart; t < tstart + 64; ++t) {
                const float at = bf2f(zc[(ptrdiff_t)t * D_IN]);
                win += at;
                const int cnt = min(s0 + t + 1, w);
                const float pv = win / (float)cnt - at;
                P[t * P_LD + ch] = (bf16)(pk2(pv, 0.f) & 0xffffu);
                const int srel = t - w + 1;
                if (s0 + srel >= 0) win -= bf2f(zc[(ptrdiff_t)srel * D_IN]);
            }
        }
        __syncthreads();
        const int fr = lane & 15, fq = lane >> 4;
#pragma unroll
        for (int g = 0; g < 4; ++g) {
            bf16x8 pf[2];
#pragma unroll
            for (int ks = 0; ks < 2; ++ks) pf[ks] = *(const LAS bf16x8*)(P + (wave * 16 + fr) * P_LD + g * 64 + ks * 32 + fq * 8);
#pragma unroll
            for (int dt = 0; dt < 4; ++dt) {
                f32x4 acc = {0.f, 0.f, 0.f, 0.f};
#pragma unroll
                for (int ks = 0; ks < 2; ++ks) {
                    const bf16x8 wf = *(const LAS bf16x8*)(PWt + (g * 64 + dt * 16 + fr) * PWT_LD + ks * 32 + fq * 8);
                    acc = __builtin_amdgcn_mfma_f32_16x16x32_bf16(wf, pf[ks], acc, 0, 0, 0);
                }
                const int col = g * 64 + dt * 16 + 4 * fq;
                const f32x4 sc = *(const f32x4*)(p.pool_scale + col);
                u32x2 o; o.x = pk2(acc[0] * sc.x, acc[1] * sc.y); o.y = pk2(acc[2] * sc.z, acc[3] * sc.w);
                *(u32x2*)(Yb + (size_t)(wave * 16 + fr) * D + col) = o;
            }
        }
        __syncthreads();
    }
#endif
#ifndef SKIP_GATE
    {
        LAS bf16* VT = (LAS bf16*)(lds + MX_VT);
        {
            const int t = tid >> 2, part = tid & 3;
            const bf16* zr = Zb + (size_t)t * D_IN + ZV_OFF + part * 96;
            float v[96]; float s1 = 0.f, s2 = 0.f;
#pragma unroll
            for (int i = 0; i < 12; ++i) { const u32x4 w = *(const u32x4*)(zr + 8 * i);
                const unsigned ww[4] = {w.x, w.y, w.z, w.w};
#pragma unroll
                for (int e = 0; e < 4; ++e) { const float a = gelu_tanh(bflo(ww[e])), b = gelu_tanh(bfhi(ww[e])); v[8 * i + 2 * e] = a; v[8 * i + 2 * e + 1] = b; s1 += a + b; s2 += a * a + b * b; } }
            s1 += __shfl_xor(s1, 1); s2 += __shfl_xor(s2, 1); s1 += __shfl_xor(s1, 2); s2 += __shfl_xor(s2, 2);
            const float mean = s1 * (1.f / W_B), var = s2 * (1.f / W_B) - mean * mean, rstd = 1.0f / sqrtf(fmaxf(var, 0.f) + EPS);
#pragma unroll
            for (int j = 0; j < 96; ++j) { const int c = part * 96 + j; const float y = (v[j] - mean) * rstd * p.sg_ln_g[c] + p.sg_ln_b[c];
                VT[c * VT_LD + t] = (bf16)(pk2(y, 0.f) & 0xffffu); }
        }
        __syncthreads();
        const int fr = lane & 15, fq = lane >> 4;
        const int nks = (wave >> 1) + 1;
        const int trow = wave * 16 + fr;
#pragma unroll 1
        for (int h = 0; h < 4; ++h) {
            bf16x8 wf[4];
#pragma unroll
            for (int ks = 0; ks < 4; ++ks) wf[ks] = (ks < nks) ? *(const bf16x8*)(p.SGW + ((size_t)(h * 128 + trow) * 128 + ks * 32 + fq * 8)) : (bf16x8){0, 0, 0, 0, 0, 0, 0, 0};
            const float sb = p.sg_b[h * 128 + trow];
#pragma unroll
            for (int dt = 0; dt < 6; ++dt) {
                f32x4 acc = {0.f, 0.f, 0.f, 0.f};
#pragma unroll
                for (int ks = 0; ks < 4; ++ks) {
                    if (ks < nks) {
                        const bf16x8 vf = *(const LAS bf16x8*)(VT + (h * 96 + dt * 16 + fr) * VT_LD + ks * 32 + fq * 8);
                        acc = __builtin_amdgcn_mfma_f32_16x16x32_bf16(vf, wf[ks], acc, 0, 0, 0);
                    }
                }
                const int col = h * 96 + dt * 16 + 4 * fq;
                const u32x2 uz = *(const u32x2*)(Zb + (size_t)trow * D_IN + ZB_OFF + col);
                const float u0 = gelu_tanh(bflo(uz.x)), u1 = gelu_tanh(bfhi(uz.x)), u2 = gelu_tanh(bflo(uz.y)), u3 = gelu_tanh(bfhi(uz.y));
                u32x2 o; o.x = pk2(u0 * (acc[0] + sb), u1 * (acc[1] + sb)); o.y = pk2(u2 * (acc[2] + sb), u3 * (acc[3] + sb));
                *(u32x2*)(Yb + (size_t)trow * D + W_A + col) = o;
            }
        }
        __syncthreads();
    }
#endif
}

__device__ __forceinline__ void attn_phase(const bf16* Q, const bf16* Kb, const bf16* Vt, bf16* O, int wave, int lane) {
    const int r32 = lane & 31, hi = lane >> 5;
    for (int blk = blockIdx.x; blk < M / 32 * 4 / 8; blk += gridDim.x) {
        const int h = blk & 3, qt = wave + 8 * (blk >> 2), q0 = qt * 32, b = q0 / SEQ;
        bf16x8 qf[16];
        const bf16* qp = Q + (size_t)(q0 + r32) * D + h * 256 + 8 * hi;
#pragma unroll
        for (int ks = 0; ks < 16; ++ks) qf[ks] = *(const bf16x8*)(qp + ks * 16);
        f32x16 S[8];
        const bf16* kp = Kb + (size_t)(b * NMEM + r32) * D + h * 256 + 8 * hi;
#pragma unroll
        for (int mt = 0; mt < 8; ++mt) {
            f32x16 acc;
#pragma unroll
            for (int e = 0; e < 16; ++e) acc[e] = 0.f;
#pragma unroll
            for (int ks = 0; ks < 16; ++ks) {
                const bf16x8 kf = *(const bf16x8*)(kp + (size_t)(mt * 32) * D + ks * 16);
                acc = __builtin_amdgcn_mfma_f32_32x32x16_bf16(kf, qf[ks], acc, 0, 0, 0);
            }
            S[mt] = acc;
        }
        float mx = -3.0e38f;
#pragma unroll
        for (int mt = 0; mt < 8; ++mt)
#pragma unroll
            for (int e = 0; e < 16; ++e) mx = fmaxf(mx, S[mt][e]);
        mx = fmaxf(mx, __shfl_xor(mx, 32));
        float sum = 0.f;
        bf16x8 pf[8][2];
#pragma unroll
        for (int mt = 0; mt < 8; ++mt) {
#pragma unroll
            for (int e = 0; e < 16; ++e) { const float pe = __expf(S[mt][e] - mx); S[mt][e] = pe; sum += pe; }
#pragma unroll
            for (int hf = 0; hf < 2; ++hf) {
                u32x4 w; w.x = pk2(S[mt][8 * hf + 0], S[mt][8 * hf + 1]); w.y = pk2(S[mt][8 * hf + 2], S[mt][8 * hf + 3]);
                w.z = pk2(S[mt][8 * hf + 4], S[mt][8 * hf + 5]); w.w = pk2(S[mt][8 * hf + 6], S[mt][8 * hf + 7]);
                pf[mt][hf] = __builtin_bit_cast(bf16x8, w);
            }
        }
        sum += __shfl_xor(sum, 32);
        const float inv = 1.0f / sum;
        const bf16* vp = Vt + (size_t)(h * 256 + r32) * MMEM + b * NMEM + 4 * hi;
        bf16* op = O + (size_t)(q0 + r32) * D + h * 256 + 4 * hi;
#pragma unroll 2
        for (int dt = 0; dt < 8; ++dt) {
            f32x16 acc;
#pragma unroll
            for (int e = 0; e < 16; ++e) acc[e] = 0.f;
#pragma unroll
            for (int mt = 0; mt < 8; ++mt)
#pragma unroll
                for (int hf = 0; hf < 2; ++hf) {
                    const bf16* vv = vp + (size_t)(dt * 32) * MMEM + mt * 32 + 16 * hf;
                    const u32x2 lo = *(const u32x2*)(vv), hi8 = *(const u32x2*)(vv + 8);
                    const u32x4 w = {lo.x, lo.y, hi8.x, hi8.y};
                    acc = __builtin_amdgcn_mfma_f32_32x32x16_bf16(__builtin_bit_cast(bf16x8, w), pf[mt][hf], acc, 0, 0, 0);
                }
#pragma unroll
            for (int j = 0; j < 4; ++j) { u32x2 o; o.x = pk2(acc[4 * j] * inv, acc[4 * j + 1] * inv); o.y = pk2(acc[4 * j + 2] * inv, acc[4 * j + 3] * inv);
                *(u32x2*)(op + dt * 32 + 8 * j) = o; }
        }
    }
}

__device__ __forceinline__ void run_gemm(LAS unsigned char* lds, const bf16* A, const bf16* Bt, int m, int n, int k, bf16* O, int ldc, const float* bias, float scale, int act, int G, int c) {
    pg8::Gemm g{A, Bt, m, n, k}; pg8::StaticOrder S; S.init(m, n, G, c);
    pg8::EpiGen E{O, ldc, bias, scale, act};
    pg8::gemm_phase<pg8::EpiGen, pg8::StaticOrder, true, true>(lds, g, S, E);
}

__global__ void __launch_bounds__(NTHREADS, 2) fwd_megakernel(Args a) {
    extern __shared__ __attribute__((aligned(16))) unsigned char lds_raw[];
    LAS unsigned char* lds = (LAS unsigned char*)lds_raw;
    cg::grid_group grid = cg::this_grid();
    const int tid0 = threadIdx.x;
    const int G = gridDim.x, bx = blockIdx.x;
    const int NGW = G * NWAVES;
    unsigned char* ws = a.ws;
    bf16* XN = (bf16*)(ws + WS_XN); bf16* Y = (bf16*)(ws + WS_Y); bf16* Z = (bf16*)(ws + WS_Z); bf16* BUFA = (bf16*)(ws + WS_BUFA); bf16* F = (bf16*)(ws + WS_F);

#pragma unroll 1
    for (int ph = a.ph_lo; ph < a.ph_hi; ++ph) {
        if (ph > a.ph_lo) grid.sync();
        int tid = tid0; asm volatile("" : "+v"(tid));
        const int lane = tid & 63, wave = __builtin_amdgcn_readfirstlane(tid >> 6);
        const int gw = bx * NWAVES + wave;
        if (ph == 0) { p0_prologue(a, lds, gw, NGW, wave, lane); __syncthreads(); continue; }
        bool is_gemm = false;
        const bf16* gA = nullptr; const bf16* gB = nullptr; int gm = 0, gn = 0, gk = 0; bf16* gO = nullptr; int gld = 0; const float* gbias = nullptr; float gscale = 1.f; int gact = 0, gG = G, gc = bx;
        const int l = (ph >= 2) ? (ph - 2) / 11 : 0, sub = (ph >= 2) ? (ph - 2) % 11 : -1;
        const unsigned char* wb = ws + WS_W + (size_t)l * WS_WL;
        if (ph == 1) {
            const int gi = (bx >> 3) & 3, kl = gi >> 1, isv = gi & 1;
            const bf16* mn = (const bf16*)(ws + WS_MN + (size_t)kl * MiB);
            const unsigned char* kwb = ws + WS_W + (size_t)kl * WS_WL;
            is_gemm = true; gk = D; gG = 8; gc = (bx < 32) ? (bx & 7) : (1 << 24);
            if (isv) { gA = (const bf16*)(kwb + WO_V); gB = mn; gm = D; gn = MMEM; gO = (bf16*)(ws + WS_VT + (size_t)kl * MiB); gld = MMEM; }
            else     { gA = mn; gB = (const bf16*)(kwb + WO_K); gm = MMEM; gn = D; gO = (bf16*)(ws + WS_KB + (size_t)kl * MiB); gld = D; }
        }
        switch (sub) {
        case 0: is_gemm = true; gA = XN; gB = (const bf16*)(wb + WO_IN); gm = M; gn = D_IN; gk = D; gO = Z; gld = D_IN; gbias = a.in[4] + (size_t)l * D_IN; break;
        case 1: {
            MixP p; p.Z = Z; p.YC = BUFA; p.pool_w = a.in[5] + (size_t)l * 4 * 64 * 64; p.pool_scale = a.in[6] + (size_t)l * W_A;
            p.sg_ln_g = a.in[7] + (size_t)l * W_B; p.sg_ln_b = a.in[8] + (size_t)l * W_B; p.sg_b = a.in[10] + (size_t)l * 4 * 128;
            p.conv_w = a.in[11] + (size_t)l * CONV_K * W_C; p.conv_b = a.in[12] + (size_t)l * W_C; p.conv_ln_g = a.in[13] + (size_t)l * W_C; p.conv_ln_b = a.in[14] + (size_t)l * W_C;
            p.SGW = (const bf16*)(ws + WS_SGW) + (size_t)l * 4 * 128 * 128;
            for (int u = bx; u < M / 128; u += G) mixer_unit(lds, p, u, tid, wave, lane);
        } break;
        case 2: is_gemm = true; gA = BUFA; gB = (const bf16*)(wb + WO_OUT); gm = M; gn = D; gk = D; gO = Y; gld = D; break;
        case 3: resnorm_phase(l == 0 ? a.in[0] : a.out, Y, a.out, XN, a.in[16] + (size_t)l * D, a.in[17] + (size_t)l * D, gw, NGW, lane); break;
        case 4: is_gemm = true; gA = XN; gB = (const bf16*)(wb + WO_Q); gm = M; gn = D; gk = D; gO = BUFA; gld = D; gscale = 0.0625f; break;
        case 5:
#ifndef SKIP_ATTN
            attn_phase(BUFA, (const bf16*)(ws + WS_KB + (size_t)l * MiB), (const bf16*)(ws + WS_VT + (size_t)l * MiB), XN, wave, lane);
#endif
            break;
        case 6: is_gemm = true; gA = XN; gB = (const bf16*)(wb + WO_O); gm = M; gn = D; gk = D; gO = Y; gld = D; break;
        case 7: resnorm_phase(a.out, Y, a.out, XN, a.in[23] + (size_t)l * D, a.in[24] + (size_t)l * D, gw, NGW, lane); break;
        case 8: is_gemm = true; gA = XN; gB = (const bf16*)(wb + WO_1); gm = M; gn = FF; gk = D; gO = F; gld = FF; gact = 1; break;
        case 9: is_gemm = true; gA = F; gB = (const bf16*)(wb + WO_2); gm = M; gn = D; gk = FF; gO = Y; gld = D; break;
        case 10: resnorm_phase(a.out, Y, a.out, XN, a.in[27] + (size_t)l * D, (l + 1 < DEPTH) ? a.in[2] + (size_t)(l + 1) * D : nullptr, gw, NGW, lane); break;
        default: break;
        }
#ifndef SKIP_GEMM
        if (is_gemm) run_gemm(lds, gA, gB, gm, gn, gk, gO, gld, gbias, gscale, gact, gG, gc);
#endif
    }
}

extern "C" void kernel_launch(void* const* d_in, const int* in_sizes, int n_in, void* d_out, int out_size, void* d_ws, size_t ws_size, hipStream_t stream) {
    static int grid = 0;
    if (grid == 0) {
        if (n_in != 28 || in_sizes[0] != M * D || out_size != M * D || ws_size < WS_END) { fprintf(stderr, "kernel_launch: unexpected shapes (n_in %d, in0 %d, out %d, ws %zu)\n", n_in, n_in > 0 ? in_sizes[0] : -1, out_size, ws_size); grid = -1; return; }
        int dev = 0, cus = 0, per_cu = 0;
        hipGetDevice(&dev);
        hipDeviceGetAttribute(&cus, hipDeviceAttributeMultiprocessorCount, dev);
        if (hipFuncSetAttribute((const void*)fwd_megakernel, hipFuncAttributeMaxDynamicSharedMemorySize, LDS_BYTES) != hipSuccess) { fprintf(stderr, "kernel_launch: hipFuncSetAttribute failed\n"); grid = -1; return; }
        if (hipOccupancyMaxActiveBlocksPerMultiprocessor(&per_cu, (const void*)fwd_megakernel, NTHREADS, LDS_BYTES) != hipSuccess || per_cu < 1) { fprintf(stderr, "kernel_launch: occupancy query says %d\n", per_cu); per_cu = 1; }
        (void)hipGetLastError();
        grid = cus * 1;
        fprintf(stderr, "kernel_launch: grid %d (cus %d, per_cu %d)\n", grid, cus, per_cu);
    }
    if (grid < 0) return;
    Args a{};
    for (int i = 0; i < 28; ++i) a.in[i] = (const float*)d_in[i];
    a.out = (float*)d_out; a.ws = (unsigned char*)d_ws;
#if MK_N_LAUNCHES == 1
    a.ph_lo = 0; a.ph_hi = NPH;
    void* args[] = {&a};
    hipError_t e = hipLaunchCooperativeKernel((const void*)fwd_megakernel, dim3(grid), dim3(NTHREADS), args, LDS_BYTES, stream);
    if (e != hipSuccess) fprintf(stderr, "kernel_launch: cooperative launch failed: %s (grid %d)\n", hipGetErrorString(e), grid);
#else
    for (int ph = 0; ph < NPH; ++ph) {
        a.ph_lo = ph; a.ph_hi = ph + 1;
        hipLaunchKernelGGL(fwd_megakernel, dim3(grid), dim3(NTHREADS), LDS_BYTES, stream, a);
    }
#endif
}
```

```cpp
#include <hip/hip_runtime.h>
#include <hip/hip_cooperative_groups.h>
#include <cstdio>
#include <cstdint>
namespace cg = cooperative_groups;
namespace pg8 {
#define PG8_LAS __attribute__((address_space(3)))
typedef unsigned short bf16_t;
typedef short bf16x8 __attribute__((ext_vector_type(8)));
typedef float f32x4 __attribute__((ext_vector_type(4)));
typedef unsigned u32x4 __attribute__((ext_vector_type(4)));
constexpr int BM = 256, BK = 64, HALF = 128, HTB = HALF * BK * 2  , STAGE_BYTES = 8 * HTB, NXCD = 8, WGM = 8;

__host__ __device__ __forceinline__ int lds_byte(int r, int c) { const int st = (r >> 4) * 2 + (c >> 5), rr = r & 15, cc = c & 31, ob = rr * 64 + cc * 2; return st * 1024 + (ob ^ (((ob >> 9) & 1) << 5)); }
__host__ __device__ __forceinline__ void stage_rc(int b, int& R, int& C) { const int st = b / 1024, sb = b % 1024, swz = sb ^ (((sb >> 9) & 1) << 5); R = (st >> 1) * 16 + swz / 64; C = (st & 1) * 32 + (swz % 64) / 2; }
__host__ __device__ __forceinline__ int perm32(int rho) { const int n = rho >> 4, i = rho & 15; return 8 * (i >> 2) + 4 * n + (i & 3); }

struct Unit { int pm, pn; };
struct Gemm { const bf16_t* A; const bf16_t* Bt; int M, N, K; };

struct StaticOrder {
    int nM, nN, nwg, G, c; int wgm = WGM;
    __host__ __device__ void init(int M, int N, int G_, int c_) { nM = M / BM; nN = N / BM; nwg = nM * nN; G = G_; c = c_; }
    __host__ __device__ bool next(int i, Unit& u) const {
        const long L = (long)i * G + c; if (L >= nwg) return false;
        int wgid = (int)L; { const int q = nwg / NXCD, r = nwg % NXCD, xcd = wgid % NXCD, off = wgid / NXCD; wgid = (xcd < r ? xcd * (q + 1) : r * (q + 1) + (xcd - r) * q) + off; }
        const int nig = wgm * nN, gid = wgid / nig, fm = gid * wgm, gsz = (nM - fm) < wgm ? (nM - fm) : wgm;
        u.pm = fm + ((wgid % nig) % gsz); u.pn = (wgid % nig) / gsz; return true;
    }
    __device__ __forceinline__ void a_ready(const Unit&) const {}
    __device__ __forceinline__ void done(const Unit&) const {}
};

__device__ __forceinline__ unsigned cvt_pk_bf16(float lo, float hi) { unsigned r; asm volatile("v_cvt_pk_bf16_f32 %0, %1, %2" : "=v"(r) : "v"(lo), "v"(hi)); return r; }
typedef float f32x2 __attribute__((ext_vector_type(2)));
__device__ __forceinline__ f32x2 gelu_pk(f32x2 v) {
    const f32x2 av = __builtin_elementwise_abs(v), d = av * 0.2316418882f + 1.0f;
    f32x2 t; t.x = __builtin_amdgcn_rcpf(d.x); t.y = __builtin_amdgcn_rcpf(d.y);
    f32x2 q = t * 0.5307027145f + (-0.7265760135f); q = q * t + 0.7107068705f; q = q * t + (-0.142248368f); q = q * t + 0.127414796f; q = q * t;
    const f32x2 s = (v * v) * (-0.72134752044f);
    f32x2 e; e.x = __builtin_amdgcn_exp2f(s.x); e.y = __builtin_amdgcn_exp2f(s.y);
    const f32x2 m = v * (q * e), r = v - m;
    f32x2 o; o.x = v.x < 0.f ? m.x : r.x; o.y = v.y < 0.f ? m.y : r.y; return o;
}

template <int ACT  > struct EpiBf16 {
    static constexpr bool PERM = true, AFTER_DRAIN = false; static_assert(ACT == 0 || ACT == 1, "EpiBf16: ACT is 0 (none) or 1 (gelu_pk)");
    bf16_t* O; int ldc; const float* bias; int split_cols; size_t split_stride; float scale0;
    __device__ __forceinline__ void operator()(const f32x4 (&acc)[2][2][4][2], const Unit& u, int wr, int wc, int fr, int fq) const {
        const int row0 = u.pm * BM + wr * 64 + fr; int colt = u.pn * BM; bf16_t* base = O;
        float sc = 1.f; if (split_cols) { const int t = colt / split_cols; base += (size_t)t * split_stride; colt -= t * split_cols; if (t == 0) sc = scale0; }
        const int col0 = colt + wc * 32 + 8 * fq, bcol0 = u.pn * BM + wc * 32 + 8 * fq;
        f32x4 bv[2][2];
#pragma unroll
        for (int bj = 0; bj < 2; ++bj)
#pragma unroll
            for (int n = 0; n < 2; ++n) bv[bj][n] = bias ? *(const f32x4*)(bias + bcol0 + bj * HALF + 4 * n) : (f32x4){0.f, 0.f, 0.f, 0.f};
#pragma unroll
        for (int ai = 0; ai < 2; ++ai)
#pragma unroll
            for (int m = 0; m < 4; ++m) { bf16_t* rowp = base + (size_t)(row0 + ai * HALF + m * 16) * ldc + col0;
#pragma unroll
                for (int bj = 0; bj < 2; ++bj) { f32x4 v0 = acc[ai][bj][m][0] + bv[bj][0], v1 = acc[ai][bj][m][1] + bv[bj][1];
                    if (ACT == 1) { f32x2 a = gelu_pk((f32x2){v0[0], v0[1]}), b = gelu_pk((f32x2){v0[2], v0[3]}), c = gelu_pk((f32x2){v1[0], v1[1]}), d = gelu_pk((f32x2){v1[2], v1[3]});
                        v0 = (f32x4){a.x, a.y, b.x, b.y}; v1 = (f32x4){c.x, c.y, d.x, d.y}; }
                    v0 = v0 * sc; v1 = v1 * sc; u32x4 w; w.x = cvt_pk_bf16(v0[0], v0[1]); w.y = cvt_pk_bf16(v0[2], v0[3]); w.z = cvt_pk_bf16(v1[0], v1[1]); w.w = cvt_pk_bf16(v1[2], v1[3]);
                    *(u32x4*)(rowp + bj * HALF) = w; } }
    }
};


struct EpiGen {
    static constexpr bool PERM = true, AFTER_DRAIN = false;
    bf16_t* O; int ldc; const PG8_LAS float* tb_bias; const PG8_LAS float* tb_rs; float scale; int act; mutable int ord;
    __device__ __forceinline__ void operator()(const f32x4 (&acc)[2][2][4][2], const Unit& u, int wr, int wc, int fr, int fq) const {
        const int row0 = u.pm * BM + wr * 64 + fr;
        const int col0 = u.pn * BM + wc * 32 + 8 * fq;
        f32x4 bv[2][2];
#pragma unroll
        for (int bj = 0; bj < 2; ++bj)
#pragma unroll
            for (int n = 0; n < 2; ++n) bv[bj][n] = tb_bias ? *(const PG8_LAS f32x4*)(tb_bias + ord * 256 + wc * 32 + 8 * fq + bj * HALF + 4 * n) : (f32x4){0.f, 0.f, 0.f, 0.f};
        const float sc = scale;
#pragma unroll
        for (int ai = 0; ai < 2; ++ai)
#pragma unroll
            for (int m = 0; m < 4; ++m) { bf16_t* rowp = O + (size_t)(row0 + ai * HALF + m * 16) * ldc + col0; const float rsv = tb_rs ? tb_rs[ord * 256 + wr * 64 + fr + ai * HALF + m * 16] : 1.f;
#pragma unroll
                for (int bj = 0; bj < 2; ++bj) { f32x4 v0 = acc[ai][bj][m][0] * rsv + bv[bj][0], v1 = acc[ai][bj][m][1] * rsv + bv[bj][1];
                    if (act) {
#pragma unroll
                        for (int e = 0; e < 4; ++e) { const float a0 = fmaxf(v0[e], 0.f), a1 = fmaxf(v1[e], 0.f); v0[e] = a0 * a0; v1[e] = a1 * a1; }
                    }
                    v0 = v0 * sc; v1 = v1 * sc; u32x4 w; w.x = cvt_pk_bf16(v0[0], v0[1]); w.y = cvt_pk_bf16(v0[2], v0[3]); w.z = cvt_pk_bf16(v1[0], v1[1]); w.w = cvt_pk_bf16(v1[2], v1[3]);
                    *(u32x4*)(rowp + bj * HALF) = w; } }
        ++ord;
    }
};


typedef unsigned u32x2 __attribute__((ext_vector_type(2)));
struct EpiResNorm {
    static constexpr bool PERM = true, AFTER_DRAIN = true;
    bf16_t* XB; float* outf; const float* g1; float* SS2; int pm_off; unsigned* xbuf; unsigned* cnt;
    __device__ __forceinline__ void fused(f32x4 (&acc)[2][2][4][2], const Unit& u, int wr, int wc, int fr, int fq, PG8_LAS unsigned char* lds, int wid, int lane) const {
        typedef __attribute__((address_space(1))) unsigned gu32_t;
        PG8_LAS float* P = (PG8_LAS float*)lds;
        PG8_LAS float* S = (PG8_LAS float*)(lds + 4096);
        const int pmg = u.pm + pm_off;
        const int col0 = u.pn * BM + wc * 32 + 8 * fq;
        u32x4 xw[2][4][2];
#pragma unroll
        for (int ai = 0; ai < 2; ++ai)
#pragma unroll
            for (int m = 0; m < 4; ++m) { const size_t off = (size_t)(pmg * BM + ai * HALF + wr * 64 + m * 16 + fr) * 1024 + col0;
#pragma unroll
                for (int bj = 0; bj < 2; ++bj) xw[ai][m][bj] = *(const u32x4*)(XB + off + bj * HALF); }
        f32x4 gv[2][2];
#pragma unroll
        for (int bj = 0; bj < 2; ++bj)
#pragma unroll
            for (int n = 0; n < 2; ++n) gv[bj][n] = *(const f32x4*)(g1 + col0 + bj * HALF + n * 4);
#pragma unroll
        for (int ai = 0; ai < 2; ++ai)
#pragma unroll
            for (int m = 0; m < 4; ++m) {
                float s = 0.f;
#pragma unroll
                for (int bj = 0; bj < 2; ++bj)
#pragma unroll
                    for (int n = 0; n < 2; ++n) { const f32x4 x = acc[ai][bj][m][n]; s += (x[0] * x[0] + x[1] * x[1]) + (x[2] * x[2] + x[3] * x[3]); }
                s += __shfl_xor(s, 16); s += __shfl_xor(s, 32);
                if (fq == 0) P[(ai * HALF + wr * 64 + m * 16 + fr) * 4 + wc] = s;
            }
        asm volatile("s_waitcnt lgkmcnt(0)" ::: "memory"); __builtin_amdgcn_s_barrier(); asm volatile("" ::: "memory");
        const int row = wid * 32 + (lane & 31);
        if (lane < 32) {
            typedef __attribute__((address_space(1))) unsigned long long gu64_t;
            const f32x4 p4 = *(const PG8_LAS f32x4*)(P + row * 4);
            const float t = (p4[0] + p4[1]) + (p4[2] + p4[3]);
            gu64_t* slot = (gu64_t*)xbuf + (size_t)(pmg * BM + row) * 4;
            __hip_atomic_store(slot + u.pn, (0x5EED0001ull << 32) | (unsigned long long)__builtin_bit_cast(unsigned, t), __ATOMIC_RELAXED, __HIP_MEMORY_SCOPE_AGENT);
            float tot = 0.f; unsigned spins = 0;
            for (;;) {
                unsigned long long w[4]; bool ok = true; tot = 0.f;
#pragma unroll
                for (int q = 0; q < 4; ++q) { w[q] = __hip_atomic_load(slot + q, __ATOMIC_RELAXED, __HIP_MEMORY_SCOPE_AGENT); ok = ok && ((unsigned)(w[q] >> 32) == 0x5EED0001u); tot += __builtin_bit_cast(float, (unsigned)w[q]); }
                if (ok || ++spins > (1u << 20)) break;
                __builtin_amdgcn_s_sleep(4);
            }
            S[row] = __builtin_amdgcn_rsqf(tot * (1.0f / 1024.0f) + 1e-6f);
        }
        asm volatile("s_waitcnt vmcnt(0) lgkmcnt(0)" ::: "memory"); __builtin_amdgcn_s_barrier(); asm volatile("" ::: "memory");
#pragma unroll
        for (int ai = 0; ai < 2; ++ai)
#pragma unroll
            for (int m = 0; m < 4; ++m) {
                const int r = ai * HALF + wr * 64 + m * 16 + fr; const float r1 = S[r]; const size_t off = (size_t)(pmg * BM + r) * 1024 + col0;
                float s2 = 0.f;
#pragma unroll
                for (int bj = 0; bj < 2; ++bj) {
                    const u32x4 w = xw[ai][m][bj];
                    f32x4 x0 = {__uint_as_float(w.x << 16), __uint_as_float(w.x & 0xffff0000u), __uint_as_float(w.y << 16), __uint_as_float(w.y & 0xffff0000u)};
                    f32x4 x1 = {__uint_as_float(w.z << 16), __uint_as_float(w.z & 0xffff0000u), __uint_as_float(w.w << 16), __uint_as_float(w.w & 0xffff0000u)};
                    x0 = x0 + acc[ai][bj][m][0] * r1 * gv[bj][0]; x1 = x1 + acc[ai][bj][m][1] * r1 * gv[bj][1];
                    s2 += ((x0[0] * x0[0] + x0[1] * x0[1]) + (x0[2] * x0[2] + x0[3] * x0[3])) + ((x1[0] * x1[0] + x1[1] * x1[1]) + (x1[2] * x1[2] + x1[3] * x1[3]));
                    if (outf) { *(f32x4*)(outf + off + bj * HALF) = x0; *(f32x4*)(outf + off + bj * HALF + 4) = x1; }
                    else { u32x4 o; o.x = cvt_pk_bf16(x0[0], x0[1]); o.y = cvt_pk_bf16(x0[2], x0[3]); o.z = cvt_pk_bf16(x1[0], x1[1]); o.w = cvt_pk_bf16(x1[2], x1[3]); *(u32x4*)(XB + off + bj * HALF) = o; }
                }
                s2 += __shfl_xor(s2, 16); s2 += __shfl_xor(s2, 32);
                if (fq == 0) P[r * 4 + wc] = s2;
            }
        asm volatile("s_waitcnt lgkmcnt(0)" ::: "memory"); __builtin_amdgcn_s_barrier(); asm volatile("" ::: "memory");
        if (!outf && lane < 32) { const f32x4 p4 = *(const PG8_LAS f32x4*)(P + row * 4); SS2[(size_t)(pmg * BM + row) * 4 + u.pn] = (p4[0] + p4[1]) + (p4[2] + p4[3]); }
        asm volatile("s_waitcnt lgkmcnt(0)" ::: "memory"); __builtin_amdgcn_s_barrier(); asm volatile("" ::: "memory");
    }
};

template <class Epi, class Sched, bool ALIGN_EPI = false, bool SP2 = false>
__device__ __forceinline__ void gemm_phase(PG8_LAS unsigned char* lds, const Gemm g, const Sched& S, const Epi& E, const int tid_in) {
    const int tid = tid_in, wid = __builtin_amdgcn_readfirstlane(tid >> 6), lane = tid & 63, wr = wid >> 2, wc = wid & 3, fr = lane & 15, fq = lane >> 4;
    const int K = g.K, nt = K / BK;
    unsigned voffA[2], voffB[2];
#pragma unroll
    for (int i = 0; i < 2; ++i) { int R, C; stage_rc(tid * 16 + i * 8192, R, C); const int Rb = Epi::PERM ? ((R & ~31) + perm32(R & 31)) : R;
        voffA[i] = (unsigned)(R * K + C) * 2u; voffB[i] = (unsigned)(Rb * K + C) * 2u; }
    const size_t kstep = (size_t)(BK * 2);
    const size_t hstep = (size_t)HALF * K * 2;
    const size_t tstep = 2 * hstep;
    const unsigned ldsw = (unsigned)wid * 1024u;
    const int aoff = lds_byte(wr * 64 + fr, fq * 8), boff = lds_byte(wc * 32 + fr, fq * 8);
#define PG8_SA(b, h) (((b) * 2 + (h)) * HTB)
#define PG8_SB(b, h) ((4 + (b) * 2 + (h)) * HTB)
#define PG8_STAGE(bufoff, gbase, voff) do { _Pragma("unroll") for (int _i = 0; _i < 2; ++_i) \
        __builtin_amdgcn_global_load_lds((const unsigned*)((const char*)(gbase) + (voff)[_i]), (PG8_LAS unsigned*)(lds + (bufoff) + ldsw + _i * 8192), 16, 0, 0); } while (0)
#define PG8_LDA(dst, b, h) do { _Pragma("unroll") for (int m = 0; m < 4; ++m) _Pragma("unroll") for (int k = 0; k < 2; ++k) dst[m][k] = *(const PG8_LAS bf16x8*)(lds + PG8_SA(b, h) + aoff + m * 2048 + k * 1024); } while (0)
#define PG8_LDB(dst, b, h) do { _Pragma("unroll") for (int n = 0; n < 2; ++n) _Pragma("unroll") for (int k = 0; k < 2; ++k) dst[n][k] = *(const PG8_LAS bf16x8*)(lds + PG8_SB(b, h) + boff + n * 2048 + k * 1024); } while (0)
#define PG8_MMA(ai, bj, At, Bt) do { __builtin_amdgcn_s_setprio(1); _Pragma("unroll") for (int m = 0; m < 4; ++m) _Pragma("unroll") for (int n = 0; n < 2; ++n) _Pragma("unroll") for (int k = 0; k < 2; ++k) \
        acc[ai][bj][m][n] = __builtin_amdgcn_mfma_f32_16x16x32_bf16(Bt[n][k], At[m][k], acc[ai][bj][m][n], 0, 0, 0); __builtin_amdgcn_s_setprio(0); } while (0)
#define PG8_WAIT_V(n) asm volatile("s_waitcnt vmcnt(" #n ")" ::: "memory")
#define PG8_WAIT_L(n) asm volatile("s_waitcnt lgkmcnt(" #n ")" ::: "memory")
#define PG8_BAR __builtin_amdgcn_s_barrier()
#define PG8_SCHED __builtin_amdgcn_sched_barrier(0)
    Unit cur, nxt; int ui = 0;
    if (!S.next(0, cur)) return;
    f32x4 acc[2][2][4][2];
#pragma unroll
    for (int a = 0; a < 2; ++a)
#pragma unroll
        for (int b = 0; b < 2; ++b)
#pragma unroll
            for (int m = 0; m < 4; ++m)
#pragma unroll
                for (int n = 0; n < 2; ++n) acc[a][b][m][n] = (f32x4){0.f, 0.f, 0.f, 0.f};
    bf16x8 At[4][2], B0[2][2], B1[2][2];
    const char* cA = (const char*)g.A + (size_t)cur.pm * tstep; const char* cB = (const char*)g.Bt + (size_t)cur.pn * tstep;
    S.a_ready(cur);
    if constexpr (SP2) {
        PG8_STAGE(PG8_SB(0, 0), cB, voffB); PG8_STAGE(PG8_SB(0, 1), cB + hstep, voffB); PG8_STAGE(PG8_SA(0, 0), cA, voffA); PG8_STAGE(PG8_SA(0, 1), cA + hstep, voffA);
        if (wr == 1) PG8_BAR;
        PG8_WAIT_V(2); PG8_BAR;
        PG8_STAGE(PG8_SB(1, 0), cB + kstep, voffB); PG8_STAGE(PG8_SA(1, 0), cA + kstep, voffA); PG8_STAGE(PG8_SB(1, 1), cB + hstep + kstep, voffB);
        PG8_WAIT_V(6); PG8_BAR;
    } else {
        PG8_STAGE(PG8_SB(0, 0), cB, voffB); PG8_STAGE(PG8_SA(0, 0), cA, voffA); PG8_STAGE(PG8_SB(0, 1), cB + hstep, voffB); PG8_STAGE(PG8_SA(0, 1), cA + hstep, voffA);
        if (wr == 1) PG8_BAR;
        PG8_WAIT_V(4); PG8_BAR;
        PG8_STAGE(PG8_SB(1, 0), cB + kstep, voffB); PG8_STAGE(PG8_SA(1, 0), cA + kstep, voffA); PG8_STAGE(PG8_SB(1, 1), cB + hstep + kstep, voffB);
        PG8_WAIT_V(6); PG8_BAR;
    }
    for (;;) {
        const bool has_next = S.next(ui + 1, nxt);
        const char* nA = has_next ? (const char*)g.A + (size_t)nxt.pm * tstep : cA; const char* nB = has_next ? (const char*)g.Bt + (size_t)nxt.pn * tstep : cB;
        for (int t = 0; t < nt; t += 2) {
            const bool last = (t == nt - 2);
            const char* a1 = cA + (size_t)(t + 1) * kstep;
            const char* a2 = last ? nA : cA + (size_t)(t + 2) * kstep; const char* b2 = last ? nB : cB + (size_t)(t + 2) * kstep;
            const char* a3 = a2 + kstep; const char* b3 = b2 + kstep;
            if (last && has_next) S.a_ready(nxt);
            if constexpr (SP2) {
            PG8_LDB(B0, 0, 0); PG8_LDB(B1, 0, 1); PG8_SCHED; PG8_LDA(At, 0, 0); PG8_STAGE(PG8_SA(1, 1), a1 + hstep, voffA);
            PG8_WAIT_V(8); PG8_WAIT_L(0); PG8_BAR; PG8_MMA(0, 0, At, B0); PG8_MMA(0, 1, At, B1); PG8_BAR; PG8_SCHED;
            PG8_LDA(At, 0, 1); PG8_STAGE(PG8_SB(0, 0), b2, voffB); PG8_STAGE(PG8_SB(0, 1), b2 + hstep, voffB); PG8_STAGE(PG8_SA(0, 0), a2, voffA);
            PG8_WAIT_V(8); PG8_WAIT_L(0); PG8_BAR; PG8_MMA(1, 0, At, B0); PG8_MMA(1, 1, At, B1); PG8_BAR; PG8_SCHED;
            PG8_LDB(B0, 1, 0); PG8_LDB(B1, 1, 1); PG8_SCHED; PG8_LDA(At, 1, 0); PG8_STAGE(PG8_SA(0, 1), a2 + hstep, voffA);
            PG8_WAIT_V(8); PG8_WAIT_L(0); PG8_BAR; PG8_MMA(0, 0, At, B0); PG8_MMA(0, 1, At, B1); PG8_BAR; PG8_SCHED;
            PG8_LDA(At, 1, 1); PG8_STAGE(PG8_SB(1, 0), b3, voffB); PG8_STAGE(PG8_SB(1, 1), b3 + hstep, voffB); PG8_STAGE(PG8_SA(1, 0), a3, voffA);
            PG8_WAIT_V(8); PG8_WAIT_L(0); PG8_BAR; PG8_MMA(1, 0, At, B0); PG8_MMA(1, 1, At, B1); PG8_BAR; PG8_SCHED;
            } else {
            PG8_LDB(B0, 0, 0); PG8_SCHED; PG8_LDA(At, 0, 0); PG8_STAGE(PG8_SA(1, 1), a1 + hstep, voffA);
            PG8_WAIT_L(8); PG8_BAR; PG8_WAIT_L(0); PG8_MMA(0, 0, At, B0); PG8_BAR; PG8_SCHED;
            PG8_LDB(B1, 0, 1); PG8_STAGE(PG8_SB(0, 0), b2, voffB);
            PG8_BAR; PG8_WAIT_L(0); PG8_MMA(0, 1, At, B1); PG8_BAR;
            PG8_LDA(At, 0, 1); PG8_STAGE(PG8_SA(0, 0), a2, voffA);
            PG8_BAR; PG8_WAIT_L(0); PG8_MMA(1, 0, At, B0); PG8_BAR; PG8_SCHED;
            PG8_STAGE(PG8_SB(0, 1), b2 + hstep, voffB);
            PG8_WAIT_V(6); PG8_BAR; PG8_MMA(1, 1, At, B1); PG8_BAR;
            PG8_LDB(B0, 1, 0); PG8_SCHED; PG8_LDA(At, 1, 0); PG8_STAGE(PG8_SA(0, 1), a2 + hstep, voffA);
            PG8_WAIT_L(8); PG8_BAR; PG8_WAIT_L(0); PG8_MMA(0, 0, At, B0); PG8_BAR; PG8_SCHED;
            PG8_LDB(B1, 1, 1); PG8_STAGE(PG8_SB(1, 0), b3, voffB);
            PG8_BAR; PG8_WAIT_L(0); PG8_MMA(0, 1, At, B1); PG8_BAR;
            PG8_LDA(At, 1, 1); PG8_STAGE(PG8_SA(1, 0), a3, voffA);
            PG8_BAR; PG8_WAIT_L(0); PG8_MMA(1, 0, At, B0); PG8_BAR; PG8_SCHED;
            PG8_STAGE(PG8_SB(1, 1), b3 + hstep, voffB);
            PG8_WAIT_V(6); PG8_BAR; PG8_MMA(1, 1, At, B1); PG8_BAR;
            }
        }
        if constexpr (ALIGN_EPI) { if (wr == 0) PG8_BAR; }
        if constexpr (!Epi::AFTER_DRAIN) { E(acc, cur, wr, wc, fr, fq); S.done(cur); }
        if (!has_next) break;
#pragma unroll
        for (int a = 0; a < 2; ++a)
#pragma unroll
            for (int b = 0; b < 2; ++b)
#pragma unroll
                for (int m = 0; m < 4; ++m)
#pragma unroll
                    for (int n = 0; n < 2; ++n) acc[a][b][m][n] = (f32x4){0.f, 0.f, 0.f, 0.f};
        cur = nxt; cA = nA; cB = nB; ++ui;
        if constexpr (ALIGN_EPI) { if (wr == 1) PG8_BAR; }
    }
    PG8_WAIT_V(0);
    if constexpr (!ALIGN_EPI) { if (wr == 0) PG8_BAR; }
    PG8_BAR;
    if constexpr (Epi::AFTER_DRAIN) { E.fused(acc, cur, wr, wc, fr, fq, lds, wid, lane); S.done(cur); }
#undef PG8_SA
#undef PG8_SB
#undef PG8_STAGE
#undef PG8_LDA
#undef PG8_LDB
#undef PG8_MMA
#undef PG8_WAIT_V
#undef PG8_WAIT_L
#undef PG8_BAR
#undef PG8_SCHED
}
}

#ifndef REP_MIXC
#define REP_MIXC 1
#endif
#ifndef REP_MIXA
#define REP_MIXA 1
#endif
#ifndef REP_MIXB
#define REP_MIXB 1
#endif
#ifndef WGM_FF1
#define WGM_FF1 4
#endif
#ifndef WGM_IN
#define WGM_IN 4
#endif
#ifndef WGM_FZ
#define WGM_FZ 8
#endif
#ifndef WGM_Q
#define WGM_Q 8
#endif
#ifndef REP_GEMM
#define REP_GEMM 1
#endif
#ifndef REP_ATTN
#define REP_ATTN 1
#endif
#ifndef REP_MIX
#define REP_MIX 1
#endif
#ifndef REP_P0
#define REP_P0 1
#endif
#ifndef REP_SYNC
#define REP_SYNC 1
#endif
#ifndef MK_N_LAUNCHES
#define MK_N_LAUNCHES 1
#endif
constexpr int BATCH = 2, SEQ = 16384, D = 1024, M = BATCH * SEQ, DEPTH = 2;
constexpr int NMEM = 256, MMEM = BATCH * NMEM;
constexpr int W_A = 256, W_B = 384, W_C = 384, D_IN = 1792, FF = 4096, CONV_K = 31;
constexpr int ZB_OFF = W_A, ZV_OFF = W_A + W_B, ZC_OFF = W_A + 2 * W_B, ZG_OFF = ZC_OFF + W_C;
constexpr float EPS = 1e-6f;
constexpr int NWAVES = 8, NTHREADS = 512;
constexpr int LDS_BYTES = 147456, MISC_OFF = 143360;
constexpr size_t WS_CTL = 0, CTL_ZERO_BYTES = 524288; constexpr int CW_BAR = 1024, CW_SEAM = 16384, SEAM_BANK = 128 * 64;
constexpr int NPH = 1 + 7 * DEPTH;

constexpr size_t MiB = 1u << 20;
constexpr size_t WS_W = 2 * MiB, WS_WL = 30 * MiB;
constexpr size_t WO_IN = 0, WO_OUT = 4 * MiB, WO_Q = 6 * MiB, WO_K = 8 * MiB, WO_V = 10 * MiB, WO_O = 12 * MiB, WO_1 = 14 * MiB, WO_2 = 22 * MiB;
constexpr size_t WS_SGW = 62 * MiB;
constexpr size_t WS_RS = 69 * MiB;
constexpr size_t WS_MN = 63 * MiB, WS_KB = 65 * MiB, WS_VT = 67 * MiB;
constexpr size_t WS_XN = 70 * MiB, WS_Y = 134 * MiB, WS_Z = 198 * MiB, WS_BUFA = 310 * MiB, WS_F = 198 * MiB, WS_XBUF = 454 * MiB  , WS_END = 462 * MiB;

typedef unsigned short bf16;
typedef short bf16x8 __attribute__((ext_vector_type(8)));
typedef float f32x4 __attribute__((ext_vector_type(4)));
typedef float f32x16 __attribute__((ext_vector_type(16)));
typedef unsigned u32x4 __attribute__((ext_vector_type(4)));
typedef unsigned u32x2 __attribute__((ext_vector_type(2)));
#define LAS __attribute__((address_space(3)))
#define LDS_WAIT() asm volatile("s_waitcnt lgkmcnt(0)" ::: "memory")

__device__ __forceinline__ float bf2f(unsigned v) { return __uint_as_float(v << 16); }
__device__ __forceinline__ float bflo(unsigned w) { return __uint_as_float(w << 16); }
__device__ __forceinline__ float bfhi(unsigned w) { return __uint_as_float(w & 0xffff0000u); }
__device__ __forceinline__ unsigned pk2(float lo, float hi) { return pg8::cvt_pk_bf16(lo, hi); }
__device__ __forceinline__ float wave_sum(float v) {
#pragma unroll
    for (int o = 1; o < 64; o <<= 1) v += __shfl_xor(v, o);
    return v;
}
__device__ __forceinline__ float fast_rcp(float x) { return __builtin_amdgcn_rcpf(x); }
__device__ __forceinline__ float fast_rsq(float x) { return __builtin_amdgcn_rsqf(x); }
__device__ __forceinline__ float sigmoidf_(float x) { return fast_rcp(1.0f + __builtin_amdgcn_exp2f(-1.4426950409f * x)); }
__device__ __forceinline__ float gelu_tanh(float x) { const float u = x + 0.044715f * x * x * x; return x * fast_rcp(1.0f + __builtin_amdgcn_exp2f(-2.302208198f * u)); }

#define XB_TMO      128
#define XB_XCNT(j)  (256  + 64 * (j))
#define XB_XSUB(j)  (1280 + 64 * (j))
#define XB_XGEN(j)  (2304 + 64 * (j))
#define XB_TOP      3328
#define XB_TOPGEN   3392
#define XCD_BAR_WORDS 3456
#define XB_SPIN_CAP (1u << 18)

__device__ __forceinline__ unsigned xb_ld(unsigned* p)              { return __hip_atomic_load(p, __ATOMIC_RELAXED, __HIP_MEMORY_SCOPE_AGENT); }
__device__ __forceinline__ unsigned xb_add(unsigned* p, unsigned v) { return __hip_atomic_fetch_add(p, v, __ATOMIC_RELAXED, __HIP_MEMORY_SCOPE_AGENT); }
__device__ __forceinline__ unsigned xb_xcc_id() { return (unsigned)__builtin_amdgcn_s_getreg((3 << 11) | 20) & 0xFu; }
#define XB_SPIN(cond, bar) do { unsigned _sp = 0; while (cond) { __builtin_amdgcn_s_sleep(1); \
    if ((++_sp & 255u) == 0u) { if (xb_ld(&(bar)[XB_TMO])) break; if (_sp > XB_SPIN_CAP) { atomicAdd(&(bar)[XB_TMO], 1u); break; } } } } while (0)

struct XcdBarrier {
    unsigned* bar; unsigned x;
    volatile LAS unsigned* st;
};

__device__ __forceinline__ XcdBarrier xcd_barrier_post(unsigned* bar, volatile LAS unsigned* st, const bool leader) {
    XcdBarrier b; b.bar = bar; b.x = xb_xcc_id(); b.st = st;
    if (leader) (void)xb_add(&bar[XB_XCNT(b.x)], 1u);
    return b;
}
__device__ __forceinline__ void xcd_barrier_complete(unsigned* bar, unsigned x, unsigned& nloc, unsigned& nx) {
    const unsigned G = gridDim.x * gridDim.y * gridDim.z;
    unsigned sum, cnt, mine, sp = 0u;
    for (;;) {
        sum = 0u; cnt = 0u; mine = 0u;
#pragma unroll
        for (unsigned j = 0; j < 16; ++j) { const unsigned c = xb_ld(&bar[XB_XCNT(j)]); sum += c; cnt += (c > 0u) ? 1u : 0u; mine = (j == x) ? c : mine; }
        if (sum == G) break;
        __builtin_amdgcn_s_sleep(1);
        if ((++sp & 255u) == 0u) { if (xb_ld(&bar[XB_TMO])) break; if (sp > XB_SPIN_CAP) { atomicAdd(&bar[XB_TMO], 1u); break; } }
    }
    nloc = mine > 0u ? mine : 1u; nx = cnt > 0u ? cnt : 1u;
}

__device__ __forceinline__ void xcd_barrier(const XcdBarrier& b, const bool leader) {
    asm volatile("s_waitcnt vmcnt(0)" ::: "memory");
    __syncthreads();
    if (leader) {
        unsigned* bar = b.bar;
        __builtin_amdgcn_s_waitcnt(0);
        unsigned nloc = b.st[0], nx = b.st[1];
        if (nloc == 0u) { xcd_barrier_complete(bar, b.x, nloc, nx); b.st[0] = nloc; b.st[1] = nx; }
        const unsigned old = xb_add(&bar[XB_XSUB(b.x)], 1u);
        const unsigned gen = old / nloc;
        if (old + 1u == (gen + 1u) * nloc) {
            __builtin_amdgcn_fence(__ATOMIC_RELEASE, "agent");
            asm volatile("s_waitcnt vmcnt(0)" ::: "memory");
            const unsigned og = xb_add(&bar[XB_TOP], 1u);
            const unsigned tg = og / nx;
            asm volatile("buffer_inv sc1" ::: "memory");
            if (og + 1u == (tg + 1u) * nx) xb_add(&bar[XB_TOPGEN], 1u);
            else XB_SPIN(xb_ld(&bar[XB_TOPGEN]) == tg, bar);
            xb_add(&bar[XB_XGEN(b.x)], 1u);
            asm volatile("s_waitcnt vmcnt(0)" ::: "memory");
        } else {
            asm volatile("buffer_inv sc1" ::: "memory");
            XB_SPIN(xb_ld(&bar[XB_XGEN(b.x)]) == gen, bar);
            asm volatile("s_waitcnt vmcnt(0)" ::: "memory");
        }
    }
    __syncthreads();
}

__device__ __forceinline__ int mk_tid(int wave0) { unsigned m = ~0u; asm volatile("" : "+s"(m)); const int l = __builtin_amdgcn_mbcnt_hi(m, __builtin_amdgcn_mbcnt_lo(m, 0u)); return wave0 * 64 + l; }

struct Args { const float* in[28]; float* out; unsigned char* ws; int ph_lo, ph_hi; };
#define AS4 __attribute__((address_space(4)))
typedef const float* cfptr; typedef float* fptr;
#define KIN(i) (*(const AS4 cfptr*)(kargs + kz + 8 * (i)))
#define KOUT (*(const AS4 fptr*)(kargs + kz + 224))

__device__ __forceinline__ void p0_transpose_item(const float* W, int K, int N, bf16* WT, LAS float* scr, int item, int lane, const float* gk) {
    const int nblk = N / 32, kb = item / nblk, nb = item % nblk, k0 = 64 * kb, n0 = 32 * nb;
#pragma unroll
    for (int i = 0; i < 8; ++i) { const int kk = 8 * i + (lane >> 3), c4 = (lane & 7) * 4; f32x4 v = *(const f32x4*)(W + (size_t)(k0 + kk) * N + n0 + c4);
        if (gk) v = v * gk[k0 + kk];
        scr[kk * 33 + c4] = v.x; scr[kk * 33 + c4 + 1] = v.y; scr[kk * 33 + c4 + 2] = v.z; scr[kk * 33 + c4 + 3] = v.w; }
    LDS_WAIT(); asm volatile("" ::: "memory");
    const int c = lane & 7;
#pragma unroll
    for (int j = 0; j < 4; ++j) { const int n = (lane >> 3) + 8 * j; const LAS float* s = scr + (8 * c) * 33 + n;
        u32x4 o; o.x = pk2(s[0 * 33], s[1 * 33]); o.y = pk2(s[2 * 33], s[3 * 33]); o.z = pk2(s[4 * 33], s[5 * 33]); o.w = pk2(s[6 * 33], s[7 * 33]);
        *(u32x4*)(WT + (size_t)(n0 + n) * K + k0 + 8 * c) = o; }
    LDS_WAIT(); asm volatile("" ::: "memory");
}
__device__ __forceinline__ void x_row_to_bf16(const float* xrow, bf16* orow, float* rs, int lane) {
    const f32x4* xr = (const f32x4*)xrow + lane;
    f32x4 v[4]; float s = 0.f;
#pragma unroll
    for (int j = 0; j < 4; ++j) { v[j] = xr[64 * j]; s += (v[j].x * v[j].x + v[j].y * v[j].y) + (v[j].z * v[j].z + v[j].w * v[j].w); }
    const float r = fast_rsq(wave_sum(s) * (1.f / D) + EPS);
    if (lane == 0) *rs = r;
    u32x2* o8 = (u32x2*)orow + lane;
#pragma unroll
    for (int j = 0; j < 4; ++j) { u32x2 w; w.x = pk2(v[j].x, v[j].y); w.y = pk2(v[j].z, v[j].w); o8[64 * j] = w; }
}
__device__ __forceinline__ void rms_row_to_bf16(const float* xrow, const float* g, bf16* orow, int lane) {
    const f32x4* xr = (const f32x4*)xrow + lane; const f32x4* gr = (const f32x4*)g + lane;
    f32x4 v[4]; float s = 0.f;
#pragma unroll
    for (int j = 0; j < 4; ++j) { v[j] = xr[64 * j]; s += (v[j].x * v[j].x + v[j].y * v[j].y) + (v[j].z * v[j].z + v[j].w * v[j].w); }
    const float r = 1.0f / sqrtf(wave_sum(s) * (1.f / D) + EPS);
    u32x2* o8 = (u32x2*)orow + lane;
#pragma unroll
    for (int j = 0; j < 4; ++j) { const f32x4 gg = gr[64 * j]; u32x2 w; w.x = pk2(v[j].x * r * gg.x, v[j].y * r * gg.y); w.y = pk2(v[j].z * r * gg.z, v[j].w * r * gg.w); o8[64 * j] = w; }
}

__device__ __forceinline__ void p0_prologue(const AS4 unsigned char* kargs, int kz, unsigned char* ws_, LAS unsigned char* lds, int gw, int NGW, int wave, int lane) {
    LAS float* scr = (LAS float*)(lds + wave * 16384);
    constexpr int I_IN = (D / 64) * (D_IN / 32), I_SQ = (D / 64) * (D / 32), I_1 = (D / 64) * (FF / 32), I_2 = (FF / 64) * (D / 32);
    constexpr int I_L = I_IN + 5 * I_SQ + I_1 + I_2;
    for (int it = gw; it < DEPTH * I_L; it += NGW) {
        const int l = it / I_L; int r = it % I_L;
        unsigned char* wb = ws_ + WS_W + (size_t)l * WS_WL;
        if (r < I_IN) { p0_transpose_item(KIN(3) + (size_t)l * D * D_IN, D, D_IN, (bf16*)(wb + WO_IN), scr, r, lane, KIN(2) + (size_t)l * D); continue; } r -= I_IN;
        if (r < I_SQ) { p0_transpose_item(KIN(15) + (size_t)l * D * D, D, D, (bf16*)(wb + WO_OUT), scr, r, lane, nullptr); continue; } r -= I_SQ;
        if (r < I_SQ) { p0_transpose_item(KIN(19) + (size_t)l * D * D, D, D, (bf16*)(wb + WO_Q), scr, r, lane, KIN(17) + (size_t)l * D); continue; } r -= I_SQ;
        if (r < I_SQ) { p0_transpose_item(KIN(20) + (size_t)l * D * D, D, D, (bf16*)(wb + WO_K), scr, r, lane, nullptr); continue; } r -= I_SQ;
        if (r < I_SQ) { p0_transpose_item(KIN(21) + (size_t)l * D * D, D, D, (bf16*)(wb + WO_V), scr, r, lane, nullptr); continue; } r -= I_SQ;
        if (r < I_SQ) { p0_transpose_item(KIN(22) + (size_t)l * D * D, D, D, (bf16*)(wb + WO_O), scr, r, lane, nullptr); continue; } r -= I_SQ;
        if (r < I_1) { p0_transpose_item(KIN(25) + (size_t)l * D * FF, D, FF, (bf16*)(wb + WO_1), scr, r, lane, KIN(24) + (size_t)l * D); continue; } r -= I_1;
        p0_transpose_item(KIN(26) + (size_t)l * FF * D, FF, D, (bf16*)(wb + WO_2), scr, r, lane, nullptr);
    }
    for (int m0 = gw; m0 < M; m0 += 4 * NGW) {
        f32x4 v[4][4];
#pragma unroll
        for (int q = 0; q < 4; ++q) { const int m = m0 + q * NGW; if (m < M) { const f32x4* xr = (const f32x4*)(KIN(0) + (size_t)m * D) + lane;
#pragma unroll
            for (int j = 0; j < 4; ++j) v[q][j] = xr[64 * j]; } }
#pragma unroll
        for (int q = 0; q < 4; ++q) { const int m = m0 + q * NGW; if (m < M) {
            float s = 0.f;
#pragma unroll
            for (int j = 0; j < 4; ++j) s += (v[q][j].x * v[q][j].x + v[q][j].y * v[q][j].y) + (v[q][j].z * v[q][j].z + v[q][j].w * v[q][j].w);
            const float wave_sum_s = wave_sum(s);
            if (lane == 0) *(f32x4*)((float*)(ws_ + WS_RS) + 4 * (size_t)m) = (f32x4){wave_sum_s, 0.f, 0.f, 0.f};
            u32x2* o8 = (u32x2*)((bf16*)(ws_ + WS_XN) + (size_t)m * D) + lane;
#pragma unroll
            for (int j = 0; j < 4; ++j) { u32x2 w; w.x = pk2(v[q][j].x, v[q][j].y); w.y = pk2(v[q][j].z, v[q][j].w); o8[64 * j] = w; } } }
    }
    for (int mm = gw; mm < DEPTH * MMEM; mm += NGW) { const int l = mm / MMEM, r = mm % MMEM;
        rms_row_to_bf16(KIN(1) + (size_t)r * D, KIN(18) + (size_t)l * D, (bf16*)(ws_ + WS_MN + (size_t)l * MiB) + (size_t)r * D, lane); }
    { const int gt = gw * 64 + lane, NGT = NGW * 64;
      for (int i = gt; i < 6 * M * 4 * 8 / 16; i += NGT) *(u32x4*)(ws_ + WS_XBUF + (size_t)i * 16) = (u32x4){0u, 0u, 0u, 0u}; }
    { const int gt = gw * 64 + lane, NGT = NGW * 64;
      for (int i = gt; i < DEPTH * 4 * 128 * 128 / 8; i += NGT) {
          const int e0 = i * 8, s0 = e0 & 127, t = (e0 >> 7) & 127;
          const f32x4 a0 = *(const f32x4*)(KIN(9) + e0), a1 = *(const f32x4*)(KIN(9) + e0 + 4);
          float v[8] = {a0.x, a0.y, a0.z, a0.w, a1.x, a1.y, a1.z, a1.w};
#pragma unroll
          for (int e = 0; e < 8; ++e) v[e] = (s0 + e <= t) ? v[e] : 0.f;
          u32x4 o; o.x = pk2(v[0], v[1]); o.y = pk2(v[2], v[3]); o.z = pk2(v[4], v[5]); o.w = pk2(v[6], v[7]);
          *(u32x4*)((bf16*)(ws_ + WS_SGW) + e0) = o; } }
}

__device__ __forceinline__ void resnorm_phase(bf16* XB, const bf16* Y, const float* g1, float* RS, float* outf, int gw, int NGW, int lane) {
    f32x4 gg[4];
#pragma unroll
    for (int j = 0; j < 4; ++j) gg[j] = ((const f32x4*)g1)[lane + 64 * j];
    for (int m0 = gw; m0 < M; m0 += 2 * NGW) {
        u32x2 yw[2][4], xw[2][4];
#pragma unroll
        for (int q = 0; q < 2; ++q) { const int m = m0 + q * NGW; if (m < M) {
            const u32x2* yr = (const u32x2*)(Y + (size_t)m * D) + lane; const u32x2* xr = (const u32x2*)(XB + (size_t)m * D) + lane;
#pragma unroll
            for (int j = 0; j < 4; ++j) { yw[q][j] = yr[64 * j]; xw[q][j] = xr[64 * j]; } } }
#pragma unroll
        for (int q = 0; q < 2; ++q) { const int m = m0 + q * NGW; if (m < M) {
            f32x4 yv[4]; float ss = 0.f;
#pragma unroll
            for (int j = 0; j < 4; ++j) { const u32x2 w = yw[q][j]; yv[j] = (f32x4){bflo(w.x), bfhi(w.x), bflo(w.y), bfhi(w.y)};
                ss += (yv[j].x * yv[j].x + yv[j].y * yv[j].y) + (yv[j].z * yv[j].z + yv[j].w * yv[j].w); }
            const float r1 = fast_rsq(wave_sum(ss) * (1.f / D) + EPS);
            float s2 = 0.f; f32x4 xv[4];
#pragma unroll
            for (int j = 0; j < 4; ++j) { const u32x2 w = xw[q][j]; xv[j] = (f32x4){bflo(w.x), bfhi(w.x), bflo(w.y), bfhi(w.y)} + yv[j] * r1 * gg[j];
                s2 += (xv[j].x * xv[j].x + xv[j].y * xv[j].y) + (xv[j].z * xv[j].z + xv[j].w * xv[j].w); }
            if (outf) { f32x4* xo = (f32x4*)(outf + (size_t)m * D) + lane;
#pragma unroll
                for (int j = 0; j < 4; ++j) xo[64 * j] = xv[j];
            } else {
                const float r2 = fast_rsq(wave_sum(s2) * (1.f / D) + EPS);
                if (lane == 0) RS[m] = r2;
                u32x2* o8 = (u32x2*)(XB + (size_t)m * D) + lane;
#pragma unroll
                for (int j = 0; j < 4; ++j) { u32x2 w; w.x = pk2(xv[j].x, xv[j].y); w.y = pk2(xv[j].z, xv[j].w); o8[64 * j] = w; }
            } } }
    }
}

struct MixP { const bf16* Z; bf16* YC; const float *pool_w, *pool_scale, *sg_ln_g, *sg_ln_b, *sg_b, *conv_w, *conv_b, *conv_ln_g, *conv_ln_b; const bf16* SGW; };

constexpr int MX_H = 0, MX_AT = 0, MX_PWT = 0, MX_P = 73728, MX_VT = 0, MX_LNT = 106496;
constexpr int PWT_LD = 72, P_LD = 264, VT_LD = 136;

__device__ __forceinline__ void mixer_unit(LAS unsigned char* lds, const MixP& p, int unit, const int wave) {
    const int t0 = unit * 128, s0 = t0 % SEQ;
    const bf16* Zb = p.Z + (size_t)t0 * D_IN;
    bf16* Yb = p.YC + (size_t)t0 * D;
    typedef float f32x2 __attribute__((ext_vector_type(2)));
#ifndef SKIP_CONV
    for (int repc = 0; repc < REP_MIXC; ++repc) {
        const int tid = mk_tid(wave), lane = tid & 63;
        LAS bf16* H = (LAS bf16*)(lds + MX_H);
#pragma unroll 1
        for (int bb = 0; bb < 2; ++bb) {
            u32x4 av[8], gv[8];
#pragma unroll
            for (int j = 0; j < 8; ++j) {
                const int idx = (bb * 8 + j) * NTHREADS + tid, r = idx / 48, vv = idx - r * 48, srel = r - 30;
                av[j] = (u32x4){0u, 0u, 0u, 0u}; gv[j] = av[j];
                if (idx < 158 * 48 && s0 + srel >= 0) { const bf16* zr = Zb + (ptrdiff_t)srel * D_IN + ZC_OFF + 8 * vv; av[j] = *(const u32x4*)zr; gv[j] = *(const u32x4*)(zr + W_C); }
            }
#pragma unroll
            for (int j = 0; j < 8; ++j) {
                const int idx = (bb * 8 + j) * NTHREADS + tid, r = idx / 48, vv = idx - r * 48;
                u32x4 o;
                o.x = pk2(bflo(av[j].x) * sigmoidf_(bflo(gv[j].x)), bfhi(av[j].x) * sigmoidf_(bfhi(gv[j].x)));
                o.y = pk2(bflo(av[j].y) * sigmoidf_(bflo(gv[j].y)), bfhi(av[j].y) * sigmoidf_(bfhi(gv[j].y)));
                o.z = pk2(bflo(av[j].z) * sigmoidf_(bflo(gv[j].z)), bfhi(av[j].z) * sigmoidf_(bfhi(gv[j].z)));
                o.w = pk2(bflo(av[j].w) * sigmoidf_(bflo(gv[j].w)), bfhi(av[j].w) * sigmoidf_(bfhi(gv[j].w)));
                if (idx < 158 * 48) *(LAS u32x4*)(H + r * W_C + 8 * vv) = o;
            }
        }
        __syncthreads();
        {
            const int tok0 = wave * 16;
            f32x2 acc[3][16];
#pragma unroll
            for (int ch = 0; ch < 3; ++ch) {
                int ln = lane; asm volatile("" : "+v"(ln));
                const int c = ch * 128 + 2 * ln;
                f32x2 w[CONV_K];
#pragma unroll
                for (int k = 0; k < CONV_K; ++k) w[k] = *(const f32x2*)(p.conv_w + k * W_C + c);
                const f32x2 cb = *(const f32x2*)(p.conv_b + c);
#pragma unroll
                for (int j = 0; j < 16; ++j) acc[ch][j] = cb;
                const LAS bf16* hp = H + tok0 * W_C + c;
#pragma unroll
                for (int q = 0; q < 46; ++q) {
                    const unsigned hw = *(const LAS unsigned*)(hp + q * W_C);
                    const f32x2 h2 = {bflo(hw), bfhi(hw)};
#pragma unroll
                    for (int j = 0; j < 16; ++j) { if (q - j >= 0 && q - j < CONV_K) acc[ch][j] = acc[ch][j] + h2 * w[q - j]; }
                }
                asm volatile("" ::: "memory");
            }
            float v[32];
#pragma unroll
            for (int j = 0; j < 16; ++j) {
                float s1 = 0.f, s2 = 0.f;
#pragma unroll
                for (int ch = 0; ch < 3; ++ch) { s1 += acc[ch][j].x + acc[ch][j].y; s2 += acc[ch][j].x * acc[ch][j].x + acc[ch][j].y * acc[ch][j].y; }
                v[j] = s1; v[16 + j] = s2;
            }
#pragma unroll
            for (int step = 0; step < 5; ++step) {
                const int half = 16 >> step, mask = 32 >> step;
                const bool b = (lane & mask) != 0;
#pragma unroll
                for (int jj = 0; jj < half; ++jj) {
                    const float send = b ? v[jj] : v[half + jj], keep = b ? v[half + jj] : v[jj];
                    v[jj] = keep + __shfl_xor(send, mask);
                }
            }
            const float vt = v[0] + __shfl_xor(v[0], 1);
            int ln = lane; asm volatile("" : "+v"(ln));
            f32x2 lgv[3], lbv[3];
#pragma unroll
            for (int ch = 0; ch < 3; ++ch) { lgv[ch] = *(const f32x2*)(p.conv_ln_g + ch * 128 + 2 * ln); lbv[ch] = *(const f32x2*)(p.conv_ln_b + ch * 128 + 2 * ln); }
#pragma unroll
            for (int j = 0; j < 16; ++j) {
                const float S1 = __int_as_float(__builtin_amdgcn_readlane(__float_as_int(vt), 2 * j));
                const float S2 = __int_as_float(__builtin_amdgcn_readlane(__float_as_int(vt), 32 + 2 * j));
                const float mean = S1 * (1.f / W_C);
                const float var = S2 * (1.f / W_C) - mean * mean;
                const float rstd = fast_rsq(fmaxf(var, 0.f) + EPS);
                bf16* yr = Yb + (size_t)(tok0 + j) * D + W_A + W_B;
#pragma unroll
                for (int ch = 0; ch < 3; ++ch) {
                    const int c = ch * 128 + 2 * ln;
                    const f32x2 lg = lgv[ch], lb = lbv[ch];
                    const float y0 = (acc[ch][j].x - mean) * rstd * lg.x + lb.x, y1 = (acc[ch][j].y - mean) * rstd * lg.y + lb.y;
                    *(unsigned*)(yr + c) = pk2(y0 * sigmoidf_(y0), y1 * sigmoidf_(y1));
                }
            }
        }
        __syncthreads();
    }
#endif
#ifndef SKIP_POOL
    for (int repa = 0; repa < REP_MIXA; ++repa) {
        const int tid = mk_tid(wave), lane = tid & 63;
        LAS bf16* PWt = (LAS bf16*)(lds + MX_PWT);
        LAS bf16* P = (LAS bf16*)(lds + MX_P);
        LAS bf16* AT = (LAS bf16*)(lds + MX_AT);
        {
            u32x4 tt[9];
#pragma unroll
            for (int j = 0; j < 9; ++j) { const int idx = j * NTHREADS + tid, r = idx >> 5, c16 = idx & 31, srel = r - 15;
                tt[j] = (u32x4){0u, 0u, 0u, 0u};
                if (idx < 143 * 32 && s0 + srel >= 0) tt[j] = *(const u32x4*)(Zb + (ptrdiff_t)srel * D_IN + c16 * 8); }
#pragma unroll
            for (int j = 0; j < 9; ++j) { const int idx = j * NTHREADS + tid, r = idx >> 5, c16 = idx & 31;
                if (idx < 143 * 32) *(LAS u32x4*)(AT + r * 256 + c16 * 8) = tt[j]; }
        }
        float pw[32];
#pragma unroll
        for (int i = 0; i < 32; ++i) pw[i] = p.pool_w[i * NTHREADS + tid];
        __syncthreads();
        {
            const int ch = tid & 255, th = tid >> 8, g = ch >> 6, w = 2 << g, tstart = th * 64;
            const LAS bf16* ac = AT + 15 * 256 + ch;
            float win = 0.f;
            for (int jj = 1; jj < w; ++jj) win += bf2f(ac[(tstart - jj) * 256]);
#pragma unroll 1
            for (int t8 = tstart; t8 < tstart + 64; t8 += 8) {
                float an[8], ao[8];
#pragma unroll
                for (int e = 0; e < 8; ++e) { an[e] = bf2f(ac[(t8 + e) * 256]); ao[e] = bf2f(ac[(t8 + e - w + 1) * 256]); }
#pragma unroll
                for (int e = 0; e < 8; ++e) {
                    win += an[e];
                    const int cnt = min(s0 + t8 + e + 1, w);
                    const float pv = win * fast_rcp((float)cnt) - an[e];
                    P[(t8 + e) * P_LD + ch] = (bf16)(pk2(pv, 0.f) & 0xffffu);
                    win -= ao[e];
                }
            }
        }
        __syncthreads();
#pragma unroll
        for (int i = 0; i < 32; ++i) { const int idx = i * NTHREADS + tid, g = idx >> 12, c = (idx >> 6) & 63, d = idx & 63;
            const int slot = (d & 32) + 16 * ((d >> 2) & 1) + 4 * ((d >> 3) & 3) + (d & 3);
            PWt[(g * 64 + slot) * PWT_LD + c] = (bf16)(pk2(pw[i], 0.f) & 0xffffu); }
        __syncthreads();
        const int fr = lane & 15, fq = lane >> 4;
#pragma unroll
        for (int g = 0; g < 4; ++g) {
            bf16x8 pf[2];
#pragma unroll
            for (int ks = 0; ks < 2; ++ks) pf[ks] = *(const LAS bf16x8*)(P + (wave * 16 + fr) * P_LD + g * 64 + ks * 32 + fq * 8);
#pragma unroll
            for (int gq = 0; gq < 2; ++gq) {
                f32x4 acc2[2];
#pragma unroll
                for (int th = 0; th < 2; ++th) {
                    f32x4 acc = {0.f, 0.f, 0.f, 0.f};
#pragma unroll
                    for (int ks = 0; ks < 2; ++ks) {
                        const bf16x8 wf = *(const LAS bf16x8*)(PWt + (g * 64 + gq * 32 + th * 16 + fr) * PWT_LD + ks * 32 + fq * 8);
                        acc = __builtin_amdgcn_mfma_f32_16x16x32_bf16(wf, pf[ks], acc, 0, 0, 0);
                    }
                    acc2[th] = acc;
                }
                const int col = g * 64 + gq * 32 + 8 * fq;
                const f32x4 sc0 = *(const f32x4*)(p.pool_scale + col), sc1 = *(const f32x4*)(p.pool_scale + col + 4);
                u32x4 o; o.x = pk2(acc2[0][0] * sc0.x, acc2[0][1] * sc0.y); o.y = pk2(acc2[0][2] * sc0.z, acc2[0][3] * sc0.w);
                o.z = pk2(acc2[1][0] * sc1.x, acc2[1][1] * sc1.y); o.w = pk2(acc2[1][2] * sc1.z, acc2[1][3] * sc1.w);
                *(u32x4*)(Yb + (size_t)(wave * 16 + fr) * D + col) = o;
            }
        }
        __syncthreads();
    }
#endif
#ifndef SKIP_GATE
    for (int repb = 0; repb < REP_MIXB; ++repb) {
        const int tid = mk_tid(wave), lane = tid & 63;
        LAS bf16* VT = (LAS bf16*)(lds + MX_VT);
        LAS f32x2* LNT = (LAS f32x2*)(lds + MX_LNT);
        if (tid < W_B) LNT[tid] = (f32x2){p.sg_ln_g[tid], p.sg_ln_b[tid]};
        {
            const int t = tid >> 2, part = tid & 3;
            const bf16* zr = Zb + (size_t)t * D_IN + ZV_OFF + part * 8;
            float v[96]; float s1 = 0.f, s2 = 0.f;
#pragma unroll
            for (int i = 0; i < 12; ++i) { const u32x4 w = *(const u32x4*)(zr + 32 * i);
                const unsigned ww[4] = {w.x, w.y, w.z, w.w};
#pragma unroll
                for (int e = 0; e < 4; ++e) { const float a = gelu_tanh(bflo(ww[e])), b = gelu_tanh(bfhi(ww[e])); v[8 * i + 2 * e] = a; v[8 * i + 2 * e + 1] = b; s1 += a + b; s2 += a * a + b * b; } }
            s1 += __shfl_xor(s1, 1); s2 += __shfl_xor(s2, 1); s1 += __shfl_xor(s1, 2); s2 += __shfl_xor(s2, 2);
            const float mean = s1 * (1.f / W_B), var = s2 * (1.f / W_B) - mean * mean, rstd = fast_rsq(fmaxf(var, 0.f) + EPS);
            __syncthreads();
#pragma unroll
            for (int j = 0; j < 96; ++j) { const int c = 8 * (4 * (j >> 3) + part) + (j & 7); const f32x2 gb = LNT[c]; const float y = (v[j] - mean) * rstd * gb.x + gb.y;
                const int slot = 32 * (j >> 3) + 16 * ((j >> 2) & 1) + 4 * part + (j & 3);
                VT[slot * VT_LD + t] = (bf16)(pk2(y, 0.f) & 0xffffu); }
        }
        const int tid2 = mk_tid(wave), lane2 = tid2 & 63;
        const int fr = lane2 & 15, fq = lane2 >> 4;
        const int nks = (wave >> 1) + 1;
        const int trow = wave * 16 + fr;
        bf16x8 wf[4][4]; u32x4 uz[4][3]; float sb[4];
#pragma unroll
        for (int h = 0; h < 4; ++h) {
#pragma unroll
            for (int ks = 0; ks < 4; ++ks) wf[h][ks] = (ks < nks) ? *(const bf16x8*)(p.SGW + ((size_t)(h * 128 + trow) * 128 + ks * 32 + fq * 8)) : (bf16x8){0, 0, 0, 0, 0, 0, 0, 0};
            sb[h] = p.sg_b[h * 128 + trow];
#pragma unroll
            for (int gq = 0; gq < 3; ++gq) uz[h][gq] = *(const u32x4*)(Zb + (size_t)trow * D_IN + ZB_OFF + h * 96 + gq * 32 + 8 * fq);
        }
        __syncthreads();
#pragma unroll
        for (int h = 0; h < 4; ++h) {
#pragma unroll
            for (int gq = 0; gq < 3; ++gq) {
                f32x4 acc2[2];
#pragma unroll
                for (int th = 0; th < 2; ++th) {
                    f32x4 acc = {0.f, 0.f, 0.f, 0.f};
#pragma unroll
                    for (int ks = 0; ks < 4; ++ks) {
                        if (ks < nks) {
                            const bf16x8 vf = *(const LAS bf16x8*)(VT + (h * 96 + gq * 32 + th * 16 + fr) * VT_LD + ks * 32 + fq * 8);
                            acc = __builtin_amdgcn_mfma_f32_16x16x32_bf16(vf, wf[h][ks], acc, 0, 0, 0);
                        }
                    }
                    acc2[th] = acc;
                }
                const u32x4 uw = uz[h][gq];
                const float u0 = gelu_tanh(bflo(uw.x)), u1 = gelu_tanh(bfhi(uw.x)), u2 = gelu_tanh(bflo(uw.y)), u3 = gelu_tanh(bfhi(uw.y));
                const float u4 = gelu_tanh(bflo(uw.z)), u5 = gelu_tanh(bfhi(uw.z)), u6 = gelu_tanh(bflo(uw.w)), u7 = gelu_tanh(bfhi(uw.w));
                u32x4 o; o.x = pk2(u0 * (acc2[0][0] + sb[h]), u1 * (acc2[0][1] + sb[h])); o.y = pk2(u2 * (acc2[0][2] + sb[h]), u3 * (acc2[0][3] + sb[h]));
                o.z = pk2(u4 * (acc2[1][0] + sb[h]), u5 * (acc2[1][1] + sb[h])); o.w = pk2(u6 * (acc2[1][2] + sb[h]), u7 * (acc2[1][3] + sb[h]));
                *(u32x4*)(Yb + (size_t)trow * D + W_A + h * 96 + gq * 32 + 8 * fq) = o;
            }
        }
        __syncthreads();
    }
#endif
}

constexpr int AT_LD = 528;
#define AT_STAGE_IDX const int tids = mk_tid(wave), t5 = tids >> 5, c16 = tids & 31;
#define AT_STAGE_IDX_W(w_) const int tids = mk_tid(w_), t5 = tids >> 5, c16 = tids & 31;
#define AT_KOFF const int pe = 16 * ((t5 >> 2) & 1) + 4 * (t5 >> 3) + (t5 & 3); const unsigned voe = (unsigned)(pe * D + c16 * 8), voo = (unsigned)((pe + 8) * D + c16 * 8);
__device__ __forceinline__ void attn_unit(LAS unsigned char* lds, const bf16* Vt, bf16* O, const int wave, const int h, const int q0, const int b, u32x4 (&st)[16], const bf16x8 (&qf)[16]) {
    const int tid = mk_tid(wave), lane = tid & 63, r32 = lane & 31, hi = lane >> 5;
    const LAS unsigned char* ka = lds + r32 * AT_LD + hi * 16;
    const LAS unsigned char* va = lds + r32 * AT_LD + hi * 32;
        __syncthreads();
        { AT_STAGE_IDX LAS unsigned char* lw = lds + t5 * AT_LD + c16 * 16;
#pragma unroll
          for (int i = 0; i < 16; ++i) *(LAS u32x4*)(lw + i * 16 * AT_LD) = st[i]; }
        __syncthreads();
        f32x16 S[8];
        {
            bf16x8 kf[2][4];
#pragma unroll
            for (int j = 0; j < 4; ++j) kf[0][j] = *(const LAS bf16x8*)(ka + j * 32);
#pragma unroll
            for (int mt = 0; mt < 8; ++mt) {
                f32x16 acc;
#pragma unroll
                for (int e = 0; e < 16; ++e) acc[e] = 0.f;
#pragma unroll
                for (int k4 = 0; k4 < 4; ++k4) {
                    const int g = mt * 4 + k4, gn = g + 1;
                    if (gn < 32) {
#pragma unroll
                        for (int j = 0; j < 4; ++j) kf[gn & 1][j] = *(const LAS bf16x8*)(ka + (gn >> 2) * 32 * AT_LD + ((gn & 3) * 4 + j) * 32);
                    }
                    __builtin_amdgcn_sched_barrier(0);
#pragma unroll
                    for (int j = 0; j < 4; ++j) acc = __builtin_amdgcn_mfma_f32_32x32x16_bf16(kf[g & 1][j], qf[k4 * 4 + j], acc, 0, 0, 0);
                    __builtin_amdgcn_sched_barrier(0);
                }
                S[mt] = acc;
            }
        }
        float mx = -3.0e38f;
#pragma unroll
        for (int mt = 0; mt < 8; ++mt)
#pragma unroll
            for (int e = 0; e < 16; ++e) mx = fmaxf(mx, S[mt][e]);
        mx = fmaxf(mx, __shfl_xor(mx, 32));
        float sum = 0.f;
        bf16x8 pf[8][2];
        const float mxl = mx * 1.4426950409f;
#pragma unroll
        for (int mt = 0; mt < 8; ++mt) {
#pragma unroll
            for (int e = 0; e < 16; ++e) { const float pe_ = __builtin_amdgcn_exp2f(S[mt][e] * 1.4426950409f - mxl); S[mt][e] = pe_; sum += pe_; }
#pragma unroll
            for (int hf = 0; hf < 2; ++hf) {
                u32x4 w; w.x = pk2(S[mt][8 * hf + 0], S[mt][8 * hf + 1]); w.y = pk2(S[mt][8 * hf + 2], S[mt][8 * hf + 3]);
                w.z = pk2(S[mt][8 * hf + 4], S[mt][8 * hf + 5]); w.w = pk2(S[mt][8 * hf + 6], S[mt][8 * hf + 7]);
                pf[mt][hf] = __builtin_bit_cast(bf16x8, w);
            }
        }
        sum += __shfl_xor(sum, 32);
        const float inv = fast_rcp(sum);
        {
            AT_STAGE_IDX const unsigned vo = (unsigned)(t5 * MMEM + c16 * 8);
            const bf16* vbase = Vt + (size_t)(h * 256) * MMEM + b * NMEM;
#pragma unroll
            for (int i = 0; i < 16; ++i) { const bf16* vb_i = vbase + (size_t)i * 16 * MMEM; st[i] = *(const u32x4*)(vb_i + vo); }
        }
        __syncthreads();
        { AT_STAGE_IDX LAS unsigned char* lw = lds + t5 * AT_LD + c16 * 16;
#pragma unroll
          for (int i = 0; i < 16; ++i) *(LAS u32x4*)(lw + i * 16 * AT_LD) = st[i]; }
        __syncthreads();
        bf16* op = O + (size_t)(q0 + r32) * D + h * 256;
        {
            bf16x8 vf[2][4];
#pragma unroll
            for (int j = 0; j < 4; ++j) vf[0][j] = *(const LAS bf16x8*)(va + ((j >> 1) * 32 + 8 * (j & 1)) * 2);
#pragma unroll
            for (int dt = 0; dt < 8; ++dt) {
                f32x16 acc;
#pragma unroll
                for (int e = 0; e < 16; ++e) acc[e] = 0.f;
#pragma unroll
                for (int q4 = 0; q4 < 4; ++q4) {
                    const int g = dt * 4 + q4, gn = g + 1;
                    if (gn < 32) {
#pragma unroll
                        for (int j = 0; j < 4; ++j) vf[gn & 1][j] = *(const LAS bf16x8*)(va + (gn >> 2) * 32 * AT_LD + (((gn & 3) * 2 + (j >> 1)) * 32 + 8 * (j & 1)) * 2);
                    }
                    __builtin_amdgcn_sched_barrier(0);
#pragma unroll
                    for (int j = 0; j < 4; ++j) acc = __builtin_amdgcn_mfma_f32_32x32x16_bf16(vf[g & 1][j], pf[q4 * 2 + (j >> 1)][j & 1], acc, 0, 0, 0);
                    __builtin_amdgcn_sched_barrier(0);
                }
                u32x2 o[4];
#pragma unroll
                for (int j = 0; j < 4; ++j) { o[j].x = pk2(acc[4 * j] * inv, acc[4 * j + 1] * inv); o[j].y = pk2(acc[4 * j + 2] * inv, acc[4 * j + 3] * inv); }
#pragma unroll
                for (int pr = 0; pr < 2; ++pr) {
                    const auto rx = __builtin_amdgcn_permlane32_swap(o[2 * pr].x, o[2 * pr + 1].x, false, false);
                    const auto ry = __builtin_amdgcn_permlane32_swap(o[2 * pr].y, o[2 * pr + 1].y, false, false);
                    const u32x4 w = {rx[0], ry[0], rx[1], ry[1]};
                    *(u32x4*)(op + dt * 32 + 8 * (2 * pr + hi)) = w; }
            }
        }
    __syncthreads();
}

constexpr int TB_Q_OFF = 139264;
struct EpiQ {
    static constexpr bool PERM = true, AFTER_DRAIN = true;
    float scale; const bf16* Kb; const bf16* Vt; bf16* O; int pm_off; int wave0;
    __device__ __forceinline__ void fused(pg8::f32x4 (&acc)[2][2][4][2], const pg8::Unit& u, int wr, int wc, int fr, int fq, LAS unsigned char* lds, int wid, int lane) const {
        const int pmg = __builtin_amdgcn_readfirstlane(u.pm + pm_off), h = __builtin_amdgcn_readfirstlane(u.pn), b = (pmg * 256) / SEQ, q0 = pmg * 256 + wave0 * 32;
        u32x4 st[16];
        const LAS float* tb = (const LAS float*)(lds + TB_Q_OFF);
#pragma unroll
        for (int ai = 0; ai < 2; ++ai)
#pragma unroll
            for (int m = 0; m < 4; ++m) { const int row = ai * 128 + wr * 64 + m * 16 + fr; const float rsv = tb[row] * scale;
#pragma unroll
                for (int bj = 0; bj < 2; ++bj) { const pg8::f32x4 v0 = acc[ai][bj][m][0] * rsv, v1 = acc[ai][bj][m][1] * rsv;
                    u32x4 w; w.x = pk2(v0[0], v0[1]); w.y = pk2(v0[2], v0[3]); w.z = pk2(v1[0], v1[1]); w.w = pk2(v1[2], v1[3]);
                    *(LAS u32x4*)(lds + row * AT_LD + (bj * 128 + wc * 32 + 8 * fq) * 2) = w; } }
        {
            AT_STAGE_IDX_W(wave0) AT_KOFF
            const bf16* kbase = Kb + (size_t)(b * NMEM) * D + h * 256;
#pragma unroll
            for (int i = 0; i < 16; ++i) { const bf16* kb_i = kbase + (size_t)(i >> 1) * 32 * D; st[i] = *(const u32x4*)(kb_i + ((i & 1) ? voo : voe)); }
        }
        __syncthreads();
        bf16x8 qf[16];
        { const int r32 = lane & 31, hi = lane >> 5; const LAS unsigned char* qp = lds + (wave0 * 32 + r32) * AT_LD + hi * 16;
#pragma unroll
          for (int ks = 0; ks < 16; ++ks) qf[ks] = *(const LAS bf16x8*)(qp + ks * 32); }
        LDS_WAIT();
        attn_unit(lds, Vt, O, wave0, h, q0, b, st, qf);
    }
};
__device__ __forceinline__ void run_gemm_qattn(LAS unsigned char* lds, const bf16* A, const bf16* Bt, const float* rs, const bf16* Kb, const bf16* Vt, bf16* O, int G, int c, const int wave0) {
#pragma unroll 1
    for (int half = 0; half < 2; ++half) {
        const int tid = mk_tid(wave0);
        pg8::Gemm g{A + (size_t)half * (M / 2) * D, Bt, M / 2, D, D}; pg8::StaticOrder S; S.init(M / 2, D, G, c); S.wgm = WGM_Q;
        { pg8::Unit u; if (S.next(0, u) && tid < 256) { const f32x4 s4 = *(const f32x4*)(rs + 4 * (size_t)((u.pm + half * (M / 2 / 256)) * 256 + tid));
            ((LAS float*)(lds + TB_Q_OFF))[tid] = fast_rsq(((s4[0] + s4[1]) + (s4[2] + s4[3])) * (1.0f / 1024.0f) + EPS); } }
        __syncthreads();
        EpiQ E{0.0625f, Kb, Vt, O, half * (M / 2 / 256), wave0};
        pg8::gemm_phase<EpiQ, pg8::StaticOrder, false, true>(lds, g, S, E, tid);
    }
}

constexpr int TB_RS_OFF = 131072, TB_BIAS_OFF = 131072 + 8192;
__device__ __forceinline__ void run_gemm(LAS unsigned char* lds, const bf16* A, const bf16* Bt, int m, int n, int k, bf16* O, int ldc, const float* bias, const float* rs, float scale, int act, int G, int c, int tid) {
    pg8::Gemm g{A, Bt, m, n, k}; pg8::StaticOrder S; S.init(m, n, G, c); S.wgm = (n == FF) ? WGM_FF1 : ((n == D_IN) ? WGM_IN : 8);
    LAS float* tb_rs = (LAS float*)(lds + TB_RS_OFF); LAS float* tb_bias = (LAS float*)(lds + TB_BIAS_OFF);
    if (rs || bias) {
        pg8::Unit u;
        for (int i = 0; i < 8 && S.next(i, u); ++i) {
            if (tid < 256) { if (rs) { const f32x4 s4 = *(const f32x4*)(rs + 4 * (size_t)(u.pm * 256 + tid)); tb_rs[i * 256 + tid] = fast_rsq(((s4[0] + s4[1]) + (s4[2] + s4[3])) * (1.0f / 1024.0f) + EPS); } }
            else if (bias && i < 4) tb_bias[i * 256 + (tid - 256)] = bias[u.pn * 256 + (tid - 256)];
        }
        __syncthreads();
    }
    pg8::EpiGen E{O, ldc, bias ? tb_bias : nullptr, rs ? tb_rs : nullptr, scale, act, 0};
    pg8::gemm_phase<pg8::EpiGen, pg8::StaticOrder, true, true>(lds, g, S, E, tid);
}

__device__ __forceinline__ void run_gemm_fused(LAS unsigned char* lds, const bf16* A, const bf16* Bt, int k, bf16* XB, float* outf, const float* g1, float* SS2, unsigned* xbuf, unsigned* cnt, int G, int c, const int wave0) {
#pragma unroll 1
    for (int half = 0; half < 2; ++half) {
        const int tid = mk_tid(wave0);
        pg8::Gemm g{A + (size_t)half * (M / 2) * k, Bt, M / 2, D, k}; pg8::StaticOrder S; S.init(M / 2, D, G, c); S.wgm = WGM_FZ;
        pg8::EpiResNorm E{XB, outf, g1, SS2, half * (M / 2 / 256), xbuf, cnt};
        pg8::gemm_phase<pg8::EpiResNorm, pg8::StaticOrder, false, true>(lds, g, S, E, tid);
    }
}

__global__ void __launch_bounds__(NTHREADS, 2) fwd_megakernel(Args a) {
    extern __shared__ __attribute__((aligned(16))) unsigned char lds_raw[];
    LAS unsigned char* lds = (LAS unsigned char*)lds_raw;
    cg::grid_group grid = cg::this_grid();
    if (a.ph_lo < 0) grid.sync();
    const int wave0 = __builtin_amdgcn_readfirstlane(threadIdx.x >> 6);
    { LAS unsigned* misc = (LAS unsigned*)(lds + MISC_OFF); const int t_ = mk_tid(wave0); if (t_ < 16) misc[t_] = 0u; }
    __syncthreads();
    const XcdBarrier xbar = xcd_barrier_post((unsigned*)(a.ws + WS_CTL) + CW_BAR, (volatile LAS unsigned*)(lds + MISC_OFF) + 8, mk_tid(wave0) == 0);
    const AS4 unsigned char* kargs = (const AS4 unsigned char*)__builtin_amdgcn_kernarg_segment_ptr();
    const int G = gridDim.x, bx = blockIdx.x;
    const int NGW = G * NWAVES;
    unsigned char* ws = a.ws;
    bf16* XN = (bf16*)(ws + WS_XN); bf16* Y = (bf16*)(ws + WS_Y); bf16* Z = (bf16*)(ws + WS_Z); bf16* BUFA = (bf16*)(ws + WS_BUFA); bf16* F = (bf16*)(ws + WS_F); float* RS = (float*)(ws + WS_RS);

#pragma unroll 1
    for (int ph = a.ph_lo; ph < a.ph_hi; ++ph) {
        if (ph > a.ph_lo) { for (int rep = 0; rep < REP_SYNC; ++rep) { xcd_barrier(xbar, mk_tid(wave0) == 0); } }
        int kz = 0; asm volatile("" : "+s"(kz));
        const int tid = mk_tid(wave0);
        const int lane = tid & 63, wave = wave0;
        const int gw = bx * NWAVES + wave;
        if (ph == 0) { for (int rep = 0; rep < REP_P0; ++rep) { p0_prologue(kargs, kz, ws, lds, gw, NGW, wave, lane); __syncthreads(); } continue; }
        bool is_gemm = false;
        const bf16* gA = nullptr; const bf16* gB = nullptr; int gm = 0, gn = 0, gk = 0; bf16* gO = nullptr; int gld = 0; const float* gbias = nullptr; const float* grs = nullptr; float gscale = 1.f; int gact = 0, gG = G, gc = bx;
        const int l = (ph - 1) / 7, sub = (ph - 1) % 7;
        const unsigned char* wb = ws + WS_W + (size_t)l * WS_WL;
        const float* fz_g = nullptr; int fz_bank = 0; float* fz_out = nullptr;
        switch (sub) {
        case 0: is_gemm = true; gA = XN; gB = (const bf16*)(wb + WO_IN); gm = M; gn = D_IN; gk = D; gO = Z; gld = D_IN; gbias = KIN(4) + (size_t)l * D_IN; grs = RS; break;
        case 1: {
            MixP p; p.Z = Z; p.YC = BUFA; p.pool_w = KIN(5) + (size_t)l * 4 * 64 * 64; p.pool_scale = KIN(6) + (size_t)l * W_A;
            p.sg_ln_g = KIN(7) + (size_t)l * W_B; p.sg_ln_b = KIN(8) + (size_t)l * W_B; p.sg_b = KIN(10) + (size_t)l * 4 * 128;
            p.conv_w = KIN(11) + (size_t)l * CONV_K * W_C; p.conv_b = KIN(12) + (size_t)l * W_C; p.conv_ln_g = KIN(13) + (size_t)l * W_C; p.conv_ln_b = KIN(14) + (size_t)l * W_C;
            p.SGW = (const bf16*)(ws + WS_SGW) + (size_t)l * 4 * 128 * 128;
            for (int rep = 0; rep < REP_MIX; ++rep) for (int u = bx; u < M / 128; u += G) mixer_unit(lds, p, u, wave0);
        } break;
        case 2: gA = BUFA; gB = (const bf16*)(wb + WO_OUT); gk = D; fz_g = KIN(16) + (size_t)l * D; fz_bank = l * 3 + 0; break;
        case 3: run_gemm_qattn(lds, XN, (const bf16*)(wb + WO_Q), RS, (const bf16*)(ws + WS_KB + (size_t)l * MiB), (const bf16*)(ws + WS_VT + (size_t)l * MiB), Z, G, bx, wave0); break;
        case 4: gA = Z; gB = (const bf16*)(wb + WO_O); gk = D; fz_g = KIN(23) + (size_t)l * D; fz_bank = l * 3 + 1; break;
        case 5: is_gemm = true; gA = XN; gB = (const bf16*)(wb + WO_1); gm = M; gn = FF; gk = D; gO = F; gld = FF; gact = 1; grs = RS; break;
        case 6: gA = F; gB = (const bf16*)(wb + WO_2); gk = FF; fz_g = KIN(27) + (size_t)l * D; fz_bank = l * 3 + 2; fz_out = (l + 1 < DEPTH) ? nullptr : KOUT; break;
        default: break;
        }
        if (fz_g) run_gemm_fused(lds, gA, gB, gk, XN, fz_out, fz_g, RS, (unsigned*)(ws + WS_XBUF) + (size_t)fz_bank * M * 4 * 2, (unsigned*)(ws + WS_CTL) + CW_SEAM + fz_bank * SEAM_BANK, G, bx, wave0);
#ifndef SKIP_GEMM
        const int npass = (ph == 1) ? 2 : 1;
#pragma unroll 1
        for (int pass = 0; pass < npass; ++pass) {
            if (pass == 1) {
                const int cb = bx - (G >= 256 ? 128 : 0);
                const int gi = (cb >> 3) & 3, kl = gi >> 1, isv = gi & 1;
                const bf16* mn = (const bf16*)(ws + WS_MN + (size_t)kl * MiB);
                const unsigned char* kwb = ws + WS_W + (size_t)kl * WS_WL;
                gk = D; gG = 8; gc = (cb >= 0 && cb < 32) ? (cb & 7) : (1 << 24); gbias = nullptr; grs = nullptr; gscale = 1.f; gact = 0;
                if (isv) { gA = (const bf16*)(kwb + WO_V); gB = mn; gm = D; gn = MMEM; gO = (bf16*)(ws + WS_VT + (size_t)kl * MiB); gld = MMEM; }
                else     { gA = mn; gB = (const bf16*)(kwb + WO_K); gm = MMEM; gn = D; gO = (bf16*)(ws + WS_KB + (size_t)kl * MiB); gld = D; }
            }
            if (is_gemm) for (int rep = 0; rep < REP_GEMM; ++rep) run_gemm(lds, gA, gB, gm, gn, gk, gO, gld, gbias, grs, gscale, gact, gG, gc, mk_tid(wave0));
        }
#endif
    }
}

extern "C" void kernel_launch(void* const* d_in, const int* in_sizes, int n_in, void* d_out, int out_size, void* d_ws, size_t ws_size, hipStream_t stream) {
    static int grid = 0;
    if (grid == 0) {
        if (n_in != 28 || in_sizes[0] != M * D || out_size != M * D || ws_size < WS_END) { fprintf(stderr, "kernel_launch: unexpected shapes (n_in %d, in0 %d, out %d, ws %zu)\n", n_in, n_in > 0 ? in_sizes[0] : -1, out_size, ws_size); grid = -1; return; }
        int dev = 0, cus = 0, per_cu = 0;
        hipGetDevice(&dev);
        hipDeviceGetAttribute(&cus, hipDeviceAttributeMultiprocessorCount, dev);
        if (hipFuncSetAttribute((const void*)fwd_megakernel, hipFuncAttributeMaxDynamicSharedMemorySize, LDS_BYTES) != hipSuccess) { fprintf(stderr, "kernel_launch: hipFuncSetAttribute failed\n"); grid = -1; return; }
        if (hipOccupancyMaxActiveBlocksPerMultiprocessor(&per_cu, (const void*)fwd_megakernel, NTHREADS, LDS_BYTES) != hipSuccess || per_cu < 1) { fprintf(stderr, "kernel_launch: occupancy query says %d\n", per_cu); per_cu = 1; }
        (void)hipGetLastError();
        grid = cus * 1;
        if (grid != 256) fprintf(stderr, "kernel_launch: %d workgroups; the fused residual+norm epilogues need exactly 256 (one 256x256 unit per workgroup)\n", grid);
        fprintf(stderr, "kernel_launch: grid %d (cus %d, per_cu %d)\n", grid, cus, per_cu);
    }
    if (grid < 0) return;
    Args a{};
    for (int i = 0; i < 28; ++i) a.in[i] = (const float*)d_in[i];
    a.out = (float*)d_out; a.ws = (unsigned char*)d_ws;
#if MK_N_LAUNCHES == 1
    if (hipMemsetAsync((char*)d_ws + WS_CTL, 0, CTL_ZERO_BYTES, stream) != hipSuccess) { fprintf(stderr, "kernel_launch: memset failed\n"); return; }
    a.ph_lo = 0; a.ph_hi = NPH;
    void* args[] = {&a};
    hipError_t e = hipLaunchCooperativeKernel((const void*)fwd_megakernel, dim3(grid), dim3(NTHREADS), args, LDS_BYTES, stream);
    if (e != hipSuccess) fprintf(stderr, "kernel_launch: cooperative launch failed: %s (grid %d)\n", hipGetErrorString(e), grid);
#else
    for (int ph = 0; ph < NPH; ++ph) {
        a.ph_lo = ph; a.ph_hi = ph + 1;
        hipLaunchKernelGGL(fwd_megakernel, dim3(grid), dim3(NTHREADS), LDS_BYTES, stream, a);
    }
#endif
}
```

```cpp
#include <hip/hip_runtime.h>
#include <hip/hip_cooperative_groups.h>
#include <cstdio>
#include <cstdint>
namespace cg = cooperative_groups;
namespace pg8 {
#define PG8_LAS __attribute__((address_space(3)))
typedef unsigned short bf16_t;
typedef short bf16x8 __attribute__((ext_vector_type(8)));
typedef float f32x4 __attribute__((ext_vector_type(4)));
typedef unsigned u32x4 __attribute__((ext_vector_type(4)));
constexpr int BM = 256, BK = 64, HALF = 128, HTB = HALF * BK * 2  , STAGE_BYTES = 8 * HTB, NXCD = 8, WGM = 8;

__host__ __device__ __forceinline__ int lds_byte(int r, int c) { const int st = (r >> 4) * 2 + (c >> 5), rr = r & 15, cc = c & 31, ob = rr * 64 + cc * 2; return st * 1024 + (ob ^ (((ob >> 9) & 1) << 5)); }
__host__ __device__ __forceinline__ void stage_rc(int b, int& R, int& C) { const int st = b / 1024, sb = b % 1024, swz = sb ^ (((sb >> 9) & 1) << 5); R = (st >> 1) * 16 + swz / 64; C = (st & 1) * 32 + (swz % 64) / 2; }
__host__ __device__ __forceinline__ int perm32(int rho) { const int n = rho >> 4, i = rho & 15; return 8 * (i >> 2) + 4 * n + (i & 3); }

struct Unit { int pm, pn; };
struct Gemm { const bf16_t* A; const bf16_t* Bt; int M, N, K; };

struct StaticOrder {
    int nM, nN, nwg, G, c; int wgm = WGM;
    __host__ __device__ void init(int M, int N, int G_, int c_) { nM = M / BM; nN = N / BM; nwg = nM * nN; G = G_; c = c_; }
    __host__ __device__ bool next(int i, Unit& u) const {
        const long L = (long)i * G + c; if (L >= nwg) return false;
        int wgid = (int)L; { const int q = nwg / NXCD, r = nwg % NXCD, xcd = wgid % NXCD, off = wgid / NXCD; wgid = (xcd < r ? xcd * (q + 1) : r * (q + 1) + (xcd - r) * q) + off; }
        const int nig = wgm * nN, gid = wgid / nig, fm = gid * wgm, gsz = (nM - fm) < wgm ? (nM - fm) : wgm;
        u.pm = fm + ((wgid % nig) % gsz); u.pn = (wgid % nig) / gsz; return true;
    }
    __device__ __forceinline__ void a_ready(const Unit&) const {}
    __device__ __forceinline__ void done(const Unit&) const {}
};

__device__ __forceinline__ unsigned cvt_pk_bf16(float lo, float hi) { unsigned r; asm volatile("v_cvt_pk_bf16_f32 %0, %1, %2" : "=v"(r) : "v"(lo), "v"(hi)); return r; }
typedef float f32x2 __attribute__((ext_vector_type(2)));
__device__ __forceinline__ f32x2 gelu_pk(f32x2 v) {
    const f32x2 av = __builtin_elementwise_abs(v), d = av * 0.2316418882f + 1.0f;
    f32x2 t; t.x = __builtin_amdgcn_rcpf(d.x); t.y = __builtin_amdgcn_rcpf(d.y);
    f32x2 q = t * 0.5307027145f + (-0.7265760135f); q = q * t + 0.7107068705f; q = q * t + (-0.142248368f); q = q * t + 0.127414796f; q = q * t;
    const f32x2 s = (v * v) * (-0.72134752044f);
    f32x2 e; e.x = __builtin_amdgcn_exp2f(s.x); e.y = __builtin_amdgcn_exp2f(s.y);
    const f32x2 m = v * (q * e), r = v - m;
    f32x2 o; o.x = v.x < 0.f ? m.x : r.x; o.y = v.y < 0.f ? m.y : r.y; return o;
}

template <int ACT  > struct EpiBf16 {
    static constexpr bool PERM = true, AFTER_DRAIN = false; static_assert(ACT == 0 || ACT == 1, "EpiBf16: ACT is 0 (none) or 1 (gelu_pk)");
    bf16_t* O; int ldc; const float* bias; int split_cols; size_t split_stride; float scale0;
    __device__ __forceinline__ void operator()(const f32x4 (&acc)[2][2][4][2], const Unit& u, int wr, int wc, int fr, int fq) const {
        const int row0 = u.pm * BM + wr * 64 + fr; int colt = u.pn * BM; bf16_t* base = O;
        float sc = 1.f; if (split_cols) { const int t = colt / split_cols; base += (size_t)t * split_stride; colt -= t * split_cols; if (t == 0) sc = scale0; }
        const int col0 = colt + wc * 32 + 8 * fq, bcol0 = u.pn * BM + wc * 32 + 8 * fq;
        f32x4 bv[2][2];
#pragma unroll
        for (int bj = 0; bj < 2; ++bj)
#pragma unroll
            for (int n = 0; n < 2; ++n) bv[bj][n] = bias ? *(const f32x4*)(bias + bcol0 + bj * HALF + 4 * n) : (f32x4){0.f, 0.f, 0.f, 0.f};
#pragma unroll
        for (int ai = 0; ai < 2; ++ai)
#pragma unroll
            for (int m = 0; m < 4; ++m) { bf16_t* rowp = base + (size_t)(row0 + ai * HALF + m * 16) * ldc + col0;
#pragma unroll
                for (int bj = 0; bj < 2; ++bj) { f32x4 v0 = acc[ai][bj][m][0] + bv[bj][0], v1 = acc[ai][bj][m][1] + bv[bj][1];
                    if (ACT == 1) { f32x2 a = gelu_pk((f32x2){v0[0], v0[1]}), b = gelu_pk((f32x2){v0[2], v0[3]}), c = gelu_pk((f32x2){v1[0], v1[1]}), d = gelu_pk((f32x2){v1[2], v1[3]});
                        v0 = (f32x4){a.x, a.y, b.x, b.y}; v1 = (f32x4){c.x, c.y, d.x, d.y}; }
                    v0 = v0 * sc; v1 = v1 * sc; u32x4 w; w.x = cvt_pk_bf16(v0[0], v0[1]); w.y = cvt_pk_bf16(v0[2], v0[3]); w.z = cvt_pk_bf16(v1[0], v1[1]); w.w = cvt_pk_bf16(v1[2], v1[3]);
                    *(u32x4*)(rowp + bj * HALF) = w; } }
    }
};


struct EpiGen {
    static constexpr bool PERM = true, AFTER_DRAIN = false;
    bf16_t* O; int ldc; const PG8_LAS float* tb_bias; const PG8_LAS float* tb_rs; float scale; int act; mutable int ord;
    __device__ __forceinline__ void operator()(const f32x4 (&acc)[2][2][4][2], const Unit& u, int wr, int wc, int fr, int fq) const {
        const int row0 = u.pm * BM + wr * 64 + fr;
        const int col0 = u.pn * BM + wc * 32 + 8 * fq;
        f32x4 bv[2][2];
#pragma unroll
        for (int bj = 0; bj < 2; ++bj)
#pragma unroll
            for (int n = 0; n < 2; ++n) bv[bj][n] = tb_bias ? *(const PG8_LAS f32x4*)(tb_bias + ord * 256 + wc * 32 + 8 * fq + bj * HALF + 4 * n) : (f32x4){0.f, 0.f, 0.f, 0.f};
        const float sc = scale;
#pragma unroll
        for (int ai = 0; ai < 2; ++ai)
#pragma unroll
            for (int m = 0; m < 4; ++m) { bf16_t* rowp = O + (size_t)(row0 + ai * HALF + m * 16) * ldc + col0; const float rsv = tb_rs ? tb_rs[ord * 256 + wr * 64 + fr + ai * HALF + m * 16] : 1.f;
#pragma unroll
                for (int bj = 0; bj < 2; ++bj) { f32x4 v0 = acc[ai][bj][m][0] * rsv + bv[bj][0], v1 = acc[ai][bj][m][1] * rsv + bv[bj][1];
                    if (act) {
#pragma unroll
                        for (int e = 0; e < 4; ++e) { const float a0 = fmaxf(v0[e], 0.f), a1 = fmaxf(v1[e], 0.f); v0[e] = a0 * a0; v1[e] = a1 * a1; }
                    }
                    v0 = v0 * sc; v1 = v1 * sc; u32x4 w; w.x = cvt_pk_bf16(v0[0], v0[1]); w.y = cvt_pk_bf16(v0[2], v0[3]); w.z = cvt_pk_bf16(v1[0], v1[1]); w.w = cvt_pk_bf16(v1[2], v1[3]);
                    *(u32x4*)(rowp + bj * HALF) = w; } }
        ++ord;
    }
};


typedef unsigned u32x2 __attribute__((ext_vector_type(2)));
struct EpiResNorm {
    static constexpr bool PERM = true, AFTER_DRAIN = true;
    bf16_t* XB; float* outf; const float* g1; float* SS2; int pm_off; unsigned* xbuf; unsigned* cnt;
    __device__ __forceinline__ void fused(f32x4 (&acc)[2][2][4][2], const Unit& u, int wr, int wc, int fr, int fq, PG8_LAS unsigned char* lds, int wid, int lane) const {
        typedef __attribute__((address_space(1))) unsigned gu32_t;
        PG8_LAS float* P = (PG8_LAS float*)lds;
        PG8_LAS float* S = (PG8_LAS float*)(lds + 4096);
        const int pmg = u.pm + pm_off;
        const int col0 = u.pn * BM + wc * 32 + 8 * fq;
        u32x4 xw[2][4][2];
#pragma unroll
        for (int ai = 0; ai < 2; ++ai)
#pragma unroll
            for (int m = 0; m < 4; ++m) { const size_t off = (size_t)(pmg * BM + ai * HALF + wr * 64 + m * 16 + fr) * 1024 + col0;
#pragma unroll
                for (int bj = 0; bj < 2; ++bj) xw[ai][m][bj] = *(const u32x4*)(XB + off + bj * HALF); }
        f32x4 gv[2][2];
#pragma unroll
        for (int bj = 0; bj < 2; ++bj)
#pragma unroll
            for (int n = 0; n < 2; ++n) gv[bj][n] = *(const f32x4*)(g1 + col0 + bj * HALF + n * 4);
#pragma unroll
        for (int ai = 0; ai < 2; ++ai)
#pragma unroll
            for (int m = 0; m < 4; ++m) {
                float s = 0.f;
#pragma unroll
                for (int bj = 0; bj < 2; ++bj)
#pragma unroll
                    for (int n = 0; n < 2; ++n) { const f32x4 x = acc[ai][bj][m][n]; s += (x[0] * x[0] + x[1] * x[1]) + (x[2] * x[2] + x[3] * x[3]); }
                s += __shfl_xor(s, 16); s += __shfl_xor(s, 32);
                if (fq == 0) P[(ai * HALF + wr * 64 + m * 16 + fr) * 4 + wc] = s;
            }
        asm volatile("s_waitcnt lgkmcnt(0)" ::: "memory"); __builtin_amdgcn_s_barrier(); asm volatile("" ::: "memory");
        const int row = wid * 32 + (lane & 31);
        if (lane < 32) {
            const f32x4 p4 = *(const PG8_LAS f32x4*)(P + row * 4);
            const float t = (p4[0] + p4[1]) + (p4[2] + p4[3]);
            __hip_atomic_store((gu32_t*)(xbuf + ((size_t)(pmg * BM + row) * 4 + u.pn)), __builtin_bit_cast(unsigned, t), __ATOMIC_RELAXED, __HIP_MEMORY_SCOPE_AGENT);
        }
        asm volatile("s_waitcnt vmcnt(0)" ::: "memory");
        if (lane == 0) __hip_atomic_fetch_add((gu32_t*)(cnt + 64 * pmg), 1u, __ATOMIC_RELAXED, __HIP_MEMORY_SCOPE_AGENT);
        if (wid == 0) {
            unsigned spins = 0;
            while ((unsigned)__builtin_amdgcn_readfirstlane(__hip_atomic_load((gu32_t*)(cnt + 64 * pmg), __ATOMIC_RELAXED, __HIP_MEMORY_SCOPE_AGENT)) < 32u) { __builtin_amdgcn_s_sleep(2); if (++spins > (1u << 22)) break; }
        }
        asm volatile("s_waitcnt vmcnt(0) lgkmcnt(0)" ::: "memory"); __builtin_amdgcn_s_barrier(); asm volatile("" ::: "memory");
        if (lane < 32) {
            const gu32_t* slot = (const gu32_t*)(xbuf + (size_t)(pmg * BM + row) * 4);
            float tot = 0.f;
#pragma unroll
            for (int t = 0; t < 4; ++t) tot += __builtin_bit_cast(float, __hip_atomic_load(slot + t, __ATOMIC_RELAXED, __HIP_MEMORY_SCOPE_AGENT));
            S[row] = __builtin_amdgcn_rsqf(tot * (1.0f / 1024.0f) + 1e-6f);
        }
        asm volatile("s_waitcnt lgkmcnt(0)" ::: "memory"); __builtin_amdgcn_s_barrier(); asm volatile("" ::: "memory");
#pragma unroll
        for (int ai = 0; ai < 2; ++ai)
#pragma unroll
            for (int m = 0; m < 4; ++m) {
                const int r = ai * HALF + wr * 64 + m * 16 + fr; const float r1 = S[r]; const size_t off = (size_t)(pmg * BM + r) * 1024 + col0;
                float s2 = 0.f;
#pragma unroll
                for (int bj = 0; bj < 2; ++bj) {
                    const u32x4 w = xw[ai][m][bj];
                    f32x4 x0 = {__uint_as_float(w.x << 16), __uint_as_float(w.x & 0xffff0000u), __uint_as_float(w.y << 16), __uint_as_float(w.y & 0xffff0000u)};
                    f32x4 x1 = {__uint_as_float(w.z << 16), __uint_as_float(w.z & 0xffff0000u), __uint_as_float(w.w << 16), __uint_as_float(w.w & 0xffff0000u)};
                    x0 = x0 + acc[ai][bj][m][0] * r1 * gv[bj][0]; x1 = x1 + acc[ai][bj][m][1] * r1 * gv[bj][1];
                    s2 += ((x0[0] * x0[0] + x0[1] * x0[1]) + (x0[2] * x0[2] + x0[3] * x0[3])) + ((x1[0] * x1[0] + x1[1] * x1[1]) + (x1[2] * x1[2] + x1[3] * x1[3]));
                    if (outf) { *(f32x4*)(outf + off + bj * HALF) = x0; *(f32x4*)(outf + off + bj * HALF + 4) = x1; }
                    else { u32x4 o; o.x = cvt_pk_bf16(x0[0], x0[1]); o.y = cvt_pk_bf16(x0[2], x0[3]); o.z = cvt_pk_bf16(x1[0], x1[1]); o.w = cvt_pk_bf16(x1[2], x1[3]); *(u32x4*)(XB + off + bj * HALF) = o; }
                }
                s2 += __shfl_xor(s2, 16); s2 += __shfl_xor(s2, 32);
                if (fq == 0) P[r * 4 + wc] = s2;
            }
        asm volatile("s_waitcnt lgkmcnt(0)" ::: "memory"); __builtin_amdgcn_s_barrier(); asm volatile("" ::: "memory");
        if (!outf && lane < 32) { const f32x4 p4 = *(const PG8_LAS f32x4*)(P + row * 4); SS2[(size_t)(pmg * BM + row) * 4 + u.pn] = (p4[0] + p4[1]) + (p4[2] + p4[3]); }
        asm volatile("s_waitcnt lgkmcnt(0)" ::: "memory"); __builtin_amdgcn_s_barrier(); asm volatile("" ::: "memory");
    }
};

template <class Epi, class Sched, bool ALIGN_EPI = false, bool SP2 = false>
__device__ __forceinline__ void gemm_phase(PG8_LAS unsigned char* lds, const Gemm g, const Sched& S, const Epi& E, const int tid_in) {
    const int tid = tid_in, wid = __builtin_amdgcn_readfirstlane(tid >> 6), lane = tid & 63, wr = wid >> 2, wc = wid & 3, fr = lane & 15, fq = lane >> 4;
    const int K = g.K, nt = K / BK;
    unsigned voffA[2], voffB[2];
#pragma unroll
    for (int i = 0; i < 2; ++i) { int R, C; stage_rc(tid * 16 + i * 8192, R, C); const int Rb = Epi::PERM ? ((R & ~31) + perm32(R & 31)) : R;
        voffA[i] = (unsigned)(R * K + C) * 2u; voffB[i] = (unsigned)(Rb * K + C) * 2u; }
    const size_t kstep = (size_t)(BK * 2);
    const size_t hstep = (size_t)HALF * K * 2;
    const size_t tstep = 2 * hstep;
    const unsigned ldsw = (unsigned)wid * 1024u;
    const int aoff = lds_byte(wr * 64 + fr, fq * 8), boff = lds_byte(wc * 32 + fr, fq * 8);
#define PG8_SA(b, h) (((b) * 2 + (h)) * HTB)
#define PG8_SB(b, h) ((4 + (b) * 2 + (h)) * HTB)
#define PG8_STAGE(bufoff, gbase, voff) do { _Pragma("unroll") for (int _i = 0; _i < 2; ++_i) \
        __builtin_amdgcn_global_load_lds((const unsigned*)((const char*)(gbase) + (voff)[_i]), (PG8_LAS unsigned*)(lds + (bufoff) + ldsw + _i * 8192), 16, 0, 0); } while (0)
#define PG8_LDA(dst, b, h) do { _Pragma("unroll") for (int m = 0; m < 4; ++m) _Pragma("unroll") for (int k = 0; k < 2; ++k) dst[m][k] = *(const PG8_LAS bf16x8*)(lds + PG8_SA(b, h) + aoff + m * 2048 + k * 1024); } while (0)
#define PG8_LDB(dst, b, h) do { _Pragma("unroll") for (int n = 0; n < 2; ++n) _Pragma("unroll") for (int k = 0; k < 2; ++k) dst[n][k] = *(const PG8_LAS bf16x8*)(lds + PG8_SB(b, h) + boff + n * 2048 + k * 1024); } while (0)
#define PG8_MMA(ai, bj, At, Bt) do { __builtin_amdgcn_s_setprio(1); _Pragma("unroll") for (int m = 0; m < 4; ++m) _Pragma("unroll") for (int n = 0; n < 2; ++n) _Pragma("unroll") for (int k = 0; k < 2; ++k) \
        acc[ai][bj][m][n] = __builtin_amdgcn_mfma_f32_16x16x32_bf16(Bt[n][k], At[m][k], acc[ai][bj][m][n], 0, 0, 0); __builtin_amdgcn_s_setprio(0); } while (0)
#define PG8_WAIT_V(n) asm volatile("s_waitcnt vmcnt(" #n ")" ::: "memory")
#define PG8_WAIT_L(n) asm volatile("s_waitcnt lgkmcnt(" #n ")" ::: "memory")
#define PG8_BAR __builtin_amdgcn_s_barrier()
#define PG8_SCHED __builtin_amdgcn_sched_barrier(0)
    Unit cur, nxt; int ui = 0;
    if (!S.next(0, cur)) return;
    f32x4 acc[2][2][4][2];
#pragma unroll
    for (int a = 0; a < 2; ++a)
#pragma unroll
        for (int b = 0; b < 2; ++b)
#pragma unroll
            for (int m = 0; m < 4; ++m)
#pragma unroll
                for (int n = 0; n < 2; ++n) acc[a][b][m][n] = (f32x4){0.f, 0.f, 0.f, 0.f};
    bf16x8 At[4][2], B0[2][2], B1[2][2];
    const char* cA = (const char*)g.A + (size_t)cur.pm * tstep; const char* cB = (const char*)g.Bt + (size_t)cur.pn * tstep;
    S.a_ready(cur);
    if constexpr (SP2) {
        PG8_STAGE(PG8_SB(0, 0), cB, voffB); PG8_STAGE(PG8_SB(0, 1), cB + hstep, voffB); PG8_STAGE(PG8_SA(0, 0), cA, voffA); PG8_STAGE(PG8_SA(0, 1), cA + hstep, voffA);
        if (wr == 1) PG8_BAR;
        PG8_WAIT_V(2); PG8_BAR;
        PG8_STAGE(PG8_SB(1, 0), cB + kstep, voffB); PG8_STAGE(PG8_SA(1, 0), cA + kstep, voffA); PG8_STAGE(PG8_SB(1, 1), cB + hstep + kstep, voffB);
        PG8_WAIT_V(6); PG8_BAR;
    } else {
        PG8_STAGE(PG8_SB(0, 0), cB, voffB); PG8_STAGE(PG8_SA(0, 0), cA, voffA); PG8_STAGE(PG8_SB(0, 1), cB + hstep, voffB); PG8_STAGE(PG8_SA(0, 1), cA + hstep, voffA);
        if (wr == 1) PG8_BAR;
        PG8_WAIT_V(4); PG8_BAR;
        PG8_STAGE(PG8_SB(1, 0), cB + kstep, voffB); PG8_STAGE(PG8_SA(1, 0), cA + kstep, voffA); PG8_STAGE(PG8_SB(1, 1), cB + hstep + kstep, voffB);
        PG8_WAIT_V(6); PG8_BAR;
    }
    for (;;) {
        const bool has_next = S.next(ui + 1, nxt);
        const char* nA = has_next ? (const char*)g.A + (size_t)nxt.pm * tstep : cA; const char* nB = has_next ? (const char*)g.Bt + (size_t)nxt.pn * tstep : cB;
        for (int t = 0; t < nt; t += 2) {
            const bool last = (t == nt - 2);
            const char* a1 = cA + (size_t)(t + 1) * kstep;
            const char* a2 = last ? nA : cA + (size_t)(t + 2) * kstep; const char* b2 = last ? nB : cB + (size_t)(t + 2) * kstep;
            const char* a3 = a2 + kstep; const char* b3 = b2 + kstep;
            if (last && has_next) S.a_ready(nxt);
            if constexpr (SP2) {
            PG8_LDB(B0, 0, 0); PG8_LDB(B1, 0, 1); PG8_SCHED; PG8_LDA(At, 0, 0); PG8_STAGE(PG8_SA(1, 1), a1 + hstep, voffA);
            PG8_WAIT_V(8); PG8_WAIT_L(0); PG8_BAR; PG8_MMA(0, 0, At, B0); PG8_MMA(0, 1, At, B1); PG8_BAR; PG8_SCHED;
            PG8_LDA(At, 0, 1); PG8_STAGE(PG8_SB(0, 0), b2, voffB); PG8_STAGE(PG8_SB(0, 1), b2 + hstep, voffB); PG8_STAGE(PG8_SA(0, 0), a2, voffA);
            PG8_WAIT_V(8); PG8_WAIT_L(0); PG8_BAR; PG8_MMA(1, 0, At, B0); PG8_MMA(1, 1, At, B1); PG8_BAR; PG8_SCHED;
            PG8_LDB(B0, 1, 0); PG8_LDB(B1, 1, 1); PG8_SCHED; PG8_LDA(At, 1, 0); PG8_STAGE(PG8_SA(0, 1), a2 + hstep, voffA);
            PG8_WAIT_V(8); PG8_WAIT_L(0); PG8_BAR; PG8_MMA(0, 0, At, B0); PG8_MMA(0, 1, At, B1); PG8_BAR; PG8_SCHED;
            PG8_LDA(At, 1, 1); PG8_STAGE(PG8_SB(1, 0), b3, voffB); PG8_STAGE(PG8_SB(1, 1), b3 + hstep, voffB); PG8_STAGE(PG8_SA(1, 0), a3, voffA);
            PG8_WAIT_V(8); PG8_WAIT_L(0); PG8_BAR; PG8_MMA(1, 0, At, B0); PG8_MMA(1, 1, At, B1); PG8_BAR; PG8_SCHED;
            } else {
            PG8_LDB(B0, 0, 0); PG8_SCHED; PG8_LDA(At, 0, 0); PG8_STAGE(PG8_SA(1, 1), a1 + hstep, voffA);
            PG8_WAIT_L(8); PG8_BAR; PG8_WAIT_L(0); PG8_MMA(0, 0, At, B0); PG8_BAR; PG8_SCHED;
            PG8_LDB(B1, 0, 1); PG8_STAGE(PG8_SB(0, 0), b2, voffB);
            PG8_BAR; PG8_WAIT_L(0); PG8_MMA(0, 1, At, B1); PG8_BAR;
            PG8_LDA(At, 0, 1); PG8_STAGE(PG8_SA(0, 0), a2, voffA);
            PG8_BAR; PG8_WAIT_L(0); PG8_MMA(1, 0, At, B0); PG8_BAR; PG8_SCHED;
            PG8_STAGE(PG8_SB(0, 1), b2 + hstep, voffB);
            PG8_WAIT_V(6); PG8_BAR; PG8_MMA(1, 1, At, B1); PG8_BAR;
            PG8_LDB(B0, 1, 0); PG8_SCHED; PG8_LDA(At, 1, 0); PG8_STAGE(PG8_SA(0, 1), a2 + hstep, voffA);
            PG8_WAIT_L(8); PG8_BAR; PG8_WAIT_L(0); PG8_MMA(0, 0, At, B0); PG8_BAR; PG8_SCHED;
            PG8_LDB(B1, 1, 1); PG8_STAGE(PG8_SB(1, 0), b3, voffB);
            PG8_BAR; PG8_WAIT_L(0); PG8_MMA(0, 1, At, B1); PG8_BAR;
            PG8_LDA(At, 1, 1); PG8_STAGE(PG8_SA(1, 0), a3, voffA);
            PG8_BAR; PG8_WAIT_L(0); PG8_MMA(1, 0, At, B0); PG8_BAR; PG8_SCHED;
            PG8_STAGE(PG8_SB(1, 1), b3 + hstep, voffB);
            PG8_WAIT_V(6); PG8_BAR; PG8_MMA(1, 1, At, B1); PG8_BAR;
            }
        }
        if constexpr (ALIGN_EPI) { if (wr == 0) PG8_BAR; }
        if constexpr (!Epi::AFTER_DRAIN) { E(acc, cur, wr, wc, fr, fq); S.done(cur); }
        if (!has_next) break;
#pragma unroll
        for (int a = 0; a < 2; ++a)
#pragma unroll
            for (int b = 0; b < 2; ++b)
#pragma unroll
                for (int m = 0; m < 4; ++m)
#pragma unroll
                    for (int n = 0; n < 2; ++n) acc[a][b][m][n] = (f32x4){0.f, 0.f, 0.f, 0.f};
        cur = nxt; cA = nA; cB = nB; ++ui;
        if constexpr (ALIGN_EPI) { if (wr == 1) PG8_BAR; }
    }
    PG8_WAIT_V(0);
    if constexpr (!ALIGN_EPI) { if (wr == 0) PG8_BAR; }
    PG8_BAR;
    if constexpr (Epi::AFTER_DRAIN) { E.fused(acc, cur, wr, wc, fr, fq, lds, wid, lane); S.done(cur); }
#undef PG8_SA
#undef PG8_SB
#undef PG8_STAGE
#undef PG8_LDA
#undef PG8_LDB
#undef PG8_MMA
#undef PG8_WAIT_V
#undef PG8_WAIT_L
#undef PG8_BAR
#undef PG8_SCHED
}
}

#ifndef REP_MIXC
#define REP_MIXC 1
#endif
#ifndef REP_MIXA
#define REP_MIXA 1
#endif
#ifndef REP_MIXB
#define REP_MIXB 1
#endif
#ifndef WGM_FF1
#define WGM_FF1 4
#endif
#ifndef WGM_IN
#define WGM_IN 4
#endif
#ifndef WGM_FZ
#define WGM_FZ 8
#endif
#ifndef WGM_Q
#define WGM_Q 8
#endif
#ifndef REP_GEMM
#define REP_GEMM 1
#endif
#ifndef REP_ATTN
#define REP_ATTN 1
#endif
#ifndef REP_MIX
#define REP_MIX 1
#endif
#ifndef REP_P0
#define REP_P0 1
#endif
#ifndef REP_SYNC
#define REP_SYNC 1
#endif
#ifndef MK_N_LAUNCHES
#define MK_N_LAUNCHES 1
#endif
constexpr int BATCH = 2, SEQ = 16384, D = 1024, M = BATCH * SEQ, DEPTH = 2;
constexpr int NMEM = 256, MMEM = BATCH * NMEM;
constexpr int W_A = 256, W_B = 384, W_C = 384, D_IN = 1792, FF = 4096, CONV_K = 31;
constexpr int ZB_OFF = W_A, ZV_OFF = W_A + W_B, ZC_OFF = W_A + 2 * W_B, ZG_OFF = ZC_OFF + W_C;
constexpr float EPS = 1e-6f;
constexpr int NWAVES = 8, NTHREADS = 512;
constexpr int LDS_BYTES = 147456, MISC_OFF = 143360;
constexpr size_t WS_CTL = 0, CTL_ZERO_BYTES = 524288; constexpr int CW_BAR = 1024, CW_SEAM = 16384, SEAM_BANK = 128 * 64;
constexpr int NPH = 1 + 7 * DEPTH;

constexpr size_t MiB = 1u << 20;
constexpr size_t WS_W = 2 * MiB, WS_WL = 30 * MiB;
constexpr size_t WO_IN = 0, WO_OUT = 4 * MiB, WO_Q = 6 * MiB, WO_K = 8 * MiB, WO_V = 10 * MiB, WO_O = 12 * MiB, WO_1 = 14 * MiB, WO_2 = 22 * MiB;
constexpr size_t WS_SGW = 62 * MiB;
constexpr size_t WS_RS = 69 * MiB;
constexpr size_t WS_MN = 63 * MiB, WS_KB = 65 * MiB, WS_VT = 67 * MiB;
constexpr size_t WS_XN = 70 * MiB, WS_Y = 134 * MiB, WS_Z = 198 * MiB, WS_BUFA = 310 * MiB, WS_F = 198 * MiB, WS_XBUF = 454 * MiB  , WS_END = 458 * MiB;

typedef unsigned short bf16;
typedef short bf16x8 __attribute__((ext_vector_type(8)));
typedef float f32x4 __attribute__((ext_vector_type(4)));
typedef float f32x16 __attribute__((ext_vector_type(16)));
typedef unsigned u32x4 __attribute__((ext_vector_type(4)));
typedef unsigned u32x2 __attribute__((ext_vector_type(2)));
#define LAS __attribute__((address_space(3)))
#define LDS_WAIT() asm volatile("s_waitcnt lgkmcnt(0)" ::: "memory")

__device__ __forceinline__ float bf2f(unsigned v) { return __uint_as_float(v << 16); }
__device__ __forceinline__ float bflo(unsigned w) { return __uint_as_float(w << 16); }
__device__ __forceinline__ float bfhi(unsigned w) { return __uint_as_float(w & 0xffff0000u); }
__device__ __forceinline__ unsigned pk2(float lo, float hi) { return pg8::cvt_pk_bf16(lo, hi); }
__device__ __forceinline__ float wave_sum(float v) {
#pragma unroll
    for (int o = 1; o < 64; o <<= 1) v += __shfl_xor(v, o);
    return v;
}
__device__ __forceinline__ float fast_rcp(float x) { return __builtin_amdgcn_rcpf(x); }
__device__ __forceinline__ float fast_rsq(float x) { return __builtin_amdgcn_rsqf(x); }
__device__ __forceinline__ float sigmoidf_(float x) { return fast_rcp(1.0f + __builtin_amdgcn_exp2f(-1.4426950409f * x)); }
__device__ __forceinline__ float gelu_tanh(float x) { const float u = x + 0.044715f * x * x * x; return x * fast_rcp(1.0f + __builtin_amdgcn_exp2f(-2.302208198f * u)); }

#define XB_TMO      128
#define XB_XCNT(j)  (256  + 64 * (j))
#define XB_XSUB(j)  (1280 + 64 * (j))
#define XB_XGEN(j)  (2304 + 64 * (j))
#define XB_TOP      3328
#define XB_TOPGEN   3392
#define XCD_BAR_WORDS 3456
#define XB_SPIN_CAP (1u << 18)

__device__ __forceinline__ unsigned xb_ld(unsigned* p)              { return __hip_atomic_load(p, __ATOMIC_RELAXED, __HIP_MEMORY_SCOPE_AGENT); }
__device__ __forceinline__ unsigned xb_add(unsigned* p, unsigned v) { return __hip_atomic_fetch_add(p, v, __ATOMIC_RELAXED, __HIP_MEMORY_SCOPE_AGENT); }
__device__ __forceinline__ unsigned xb_xcc_id() { return (unsigned)__builtin_amdgcn_s_getreg((3 << 11) | 20) & 0xFu; }
#define XB_SPIN(cond, bar) do { unsigned _sp = 0; while (cond) { __builtin_amdgcn_s_sleep(1); \
    if ((++_sp & 255u) == 0u) { if (xb_ld(&(bar)[XB_TMO])) break; if (_sp > XB_SPIN_CAP) { atomicAdd(&(bar)[XB_TMO], 1u); break; } } } } while (0)

struct XcdBarrier {
    unsigned* bar; unsigned x;
    volatile LAS unsigned* st;
};

__device__ __forceinline__ XcdBarrier xcd_barrier_post(unsigned* bar, volatile LAS unsigned* st, const bool leader) {
    XcdBarrier b; b.bar = bar; b.x = xb_xcc_id(); b.st = st;
    if (leader) (void)xb_add(&bar[XB_XCNT(b.x)], 1u);
    return b;
}
__device__ __forceinline__ void xcd_barrier_complete(unsigned* bar, unsigned x, unsigned& nloc, unsigned& nx) {
    const unsigned G = gridDim.x * gridDim.y * gridDim.z;
    unsigned sum, cnt, mine, sp = 0u;
    for (;;) {
        sum = 0u; cnt = 0u; mine = 0u;
#pragma unroll
        for (unsigned j = 0; j < 16; ++j) { const unsigned c = xb_ld(&bar[XB_XCNT(j)]); sum += c; cnt += (c > 0u) ? 1u : 0u; mine = (j == x) ? c : mine; }
        if (sum == G) break;
        __builtin_amdgcn_s_sleep(1);
        if ((++sp & 255u) == 0u) { if (xb_ld(&bar[XB_TMO])) break; if (sp > XB_SPIN_CAP) { atomicAdd(&bar[XB_TMO], 1u); break; } }
    }
    nloc = mine > 0u ? mine : 1u; nx = cnt > 0u ? cnt : 1u;
}

__device__ __forceinline__ void xcd_barrier(const XcdBarrier& b, const bool leader) {
    asm volatile("s_waitcnt vmcnt(0)" ::: "memory");
    __syncthreads();
    if (leader) {
        unsigned* bar = b.bar;
        __builtin_amdgcn_s_waitcnt(0);
        unsigned nloc = b.st[0], nx = b.st[1];
        if (nloc == 0u) { xcd_barrier_complete(bar, b.x, nloc, nx); b.st[0] = nloc; b.st[1] = nx; }
        const unsigned old = xb_add(&bar[XB_XSUB(b.x)], 1u);
        const unsigned gen = old / nloc;
        if (old + 1u == (gen + 1u) * nloc) {
            __builtin_amdgcn_fence(__ATOMIC_RELEASE, "agent");
            asm volatile("s_waitcnt vmcnt(0)" ::: "memory");
            const unsigned og = xb_add(&bar[XB_TOP], 1u);
            const unsigned tg = og / nx;
            asm volatile("buffer_inv sc1" ::: "memory");
            if (og + 1u == (tg + 1u) * nx) xb_add(&bar[XB_TOPGEN], 1u);
            else XB_SPIN(xb_ld(&bar[XB_TOPGEN]) == tg, bar);
            xb_add(&bar[XB_XGEN(b.x)], 1u);
            asm volatile("s_waitcnt vmcnt(0)" ::: "memory");
        } else {
            if (old + 2u == (gen + 1u) * nloc) asm volatile("buffer_wbl2 sc1" ::: "memory");
            asm volatile("buffer_inv sc1" ::: "memory");
            XB_SPIN(xb_ld(&bar[XB_XGEN(b.x)]) == gen, bar);
            asm volatile("s_waitcnt vmcnt(0)" ::: "memory");
        }
    }
    __syncthreads();
}

__device__ __forceinline__ int mk_tid(int wave0) { unsigned m = ~0u; asm volatile("" : "+s"(m)); const int l = __builtin_amdgcn_mbcnt_hi(m, __builtin_amdgcn_mbcnt_lo(m, 0u)); return wave0 * 64 + l; }

struct Args { const float* in[28]; float* out; unsigned char* ws; int ph_lo, ph_hi; };
#define AS4 __attribute__((address_space(4)))
typedef const float* cfptr; typedef float* fptr;
#define KIN(i) (*(const AS4 cfptr*)(kargs + kz + 8 * (i)))
#define KOUT (*(const AS4 fptr*)(kargs + kz + 224))

__device__ __forceinline__ void p0_transpose_item(const float* W, int K, int N, bf16* WT, LAS float* scr, int item, int lane, const float* gk) {
    const int nblk = N / 32, kb = item / nblk, nb = item % nblk, k0 = 64 * kb, n0 = 32 * nb;
#pragma unroll
    for (int i = 0; i < 8; ++i) { const int kk = 8 * i + (lane >> 3), c4 = (lane & 7) * 4; f32x4 v = *(const f32x4*)(W + (size_t)(k0 + kk) * N + n0 + c4);
        if (gk) v = v * gk[k0 + kk];
        scr[kk * 33 + c4] = v.x; scr[kk * 33 + c4 + 1] = v.y; scr[kk * 33 + c4 + 2] = v.z; scr[kk * 33 + c4 + 3] = v.w; }
    LDS_WAIT(); asm volatile("" ::: "memory");
    const int c = lane & 7;
#pragma unroll
    for (int j = 0; j < 4; ++j) { const int n = (lane >> 3) + 8 * j; const LAS float* s = scr + (8 * c) * 33 + n;
        u32x4 o; o.x = pk2(s[0 * 33], s[1 * 33]); o.y = pk2(s[2 * 33], s[3 * 33]); o.z = pk2(s[4 * 33], s[5 * 33]); o.w = pk2(s[6 * 33], s[7 * 33]);
        *(u32x4*)(WT + (size_t)(n0 + n) * K + k0 + 8 * c) = o; }
    LDS_WAIT(); asm volatile("" ::: "memory");
}
__device__ __forceinline__ void x_row_to_bf16(const float* xrow, bf16* orow, float* rs, int lane) {
    const f32x4* xr = (const f32x4*)xrow + lane;
    f32x4 v[4]; float s = 0.f;
#pragma unroll
    for (int j = 0; j < 4; ++j) { v[j] = xr[64 * j]; s += (v[j].x * v[j].x + v[j].y * v[j].y) + (v[j].z * v[j].z + v[j].w * v[j].w); }
    const float r = fast_rsq(wave_sum(s) * (1.f / D) + EPS);
    if (lane == 0) *rs = r;
    u32x2* o8 = (u32x2*)orow + lane;
#pragma unroll
    for (int j = 0; j < 4; ++j) { u32x2 w; w.x = pk2(v[j].x, v[j].y); w.y = pk2(v[j].z, v[j].w); o8[64 * j] = w; }
}
__device__ __forceinline__ void rms_row_to_bf16(const float* xrow, const float* g, bf16* orow, int lane) {
    const f32x4* xr = (const f32x4*)xrow + lane; const f32x4* gr = (const f32x4*)g + lane;
    f32x4 v[4]; float s = 0.f;
#pragma unroll
    for (int j = 0; j < 4; ++j) { v[j] = xr[64 * j]; s += (v[j].x * v[j].x + v[j].y * v[j].y) + (v[j].z * v[j].z + v[j].w * v[j].w); }
    const float r = 1.0f / sqrtf(wave_sum(s) * (1.f / D) + EPS);
    u32x2* o8 = (u32x2*)orow + lane;
#pragma unroll
    for (int j = 0; j < 4; ++j) { const f32x4 gg = gr[64 * j]; u32x2 w; w.x = pk2(v[j].x * r * gg.x, v[j].y * r * gg.y); w.y = pk2(v[j].z * r * gg.z, v[j].w * r * gg.w); o8[64 * j] = w; }
}

__device__ __forceinline__ void p0_prologue(const AS4 unsigned char* kargs, int kz, unsigned char* ws_, LAS unsigned char* lds, int gw, int NGW, int wave, int lane) {
    LAS float* scr = (LAS float*)(lds + wave * 16384);
    constexpr int I_IN = (D / 64) * (D_IN / 32), I_SQ = (D / 64) * (D / 32), I_1 = (D / 64) * (FF / 32), I_2 = (FF / 64) * (D / 32);
    constexpr int I_L = I_IN + 5 * I_SQ + I_1 + I_2;
    for (int it = gw; it < DEPTH * I_L; it += NGW) {
        const int l = it / I_L; int r = it % I_L;
        unsigned char* wb = ws_ + WS_W + (size_t)l * WS_WL;
        if (r < I_IN) { p0_transpose_item(KIN(3) + (size_t)l * D * D_IN, D, D_IN, (bf16*)(wb + WO_IN), scr, r, lane, KIN(2) + (size_t)l * D); continue; } r -= I_IN;
        if (r < I_SQ) { p0_transpose_item(KIN(15) + (size_t)l * D * D, D, D, (bf16*)(wb + WO_OUT), scr, r, lane, nullptr); continue; } r -= I_SQ;
        if (r < I_SQ) { p0_transpose_item(KIN(19) + (size_t)l * D * D, D, D, (bf16*)(wb + WO_Q), scr, r, lane, KIN(17) + (size_t)l * D); continue; } r -= I_SQ;
        if (r < I_SQ) { p0_transpose_item(KIN(20) + (size_t)l * D * D, D, D, (bf16*)(wb + WO_K), scr, r, lane, nullptr); continue; } r -= I_SQ;
        if (r < I_SQ) { p0_transpose_item(KIN(21) + (size_t)l * D * D, D, D, (bf16*)(wb + WO_V), scr, r, lane, nullptr); continue; } r -= I_SQ;
        if (r < I_SQ) { p0_transpose_item(KIN(22) + (size_t)l * D * D, D, D, (bf16*)(wb + WO_O), scr, r, lane, nullptr); continue; } r -= I_SQ;
        if (r < I_1) { p0_transpose_item(KIN(25) + (size_t)l * D * FF, D, FF, (bf16*)(wb + WO_1), scr, r, lane, KIN(24) + (size_t)l * D); continue; } r -= I_1;
        p0_transpose_item(KIN(26) + (size_t)l * FF * D, FF, D, (bf16*)(wb + WO_2), scr, r, lane, nullptr);
    }
    for (int m0 = gw; m0 < M; m0 += 4 * NGW) {
        f32x4 v[4][4];
#pragma unroll
        for (int q = 0; q < 4; ++q) { const int m = m0 + q * NGW; if (m < M) { const f32x4* xr = (const f32x4*)(KIN(0) + (size_t)m * D) + lane;
#pragma unroll
            for (int j = 0; j < 4; ++j) v[q][j] = xr[64 * j]; } }
#pragma unroll
        for (int q = 0; q < 4; ++q) { const int m = m0 + q * NGW; if (m < M) {
            float s = 0.f;
#pragma unroll
            for (int j = 0; j < 4; ++j) s += (v[q][j].x * v[q][j].x + v[q][j].y * v[q][j].y) + (v[q][j].z * v[q][j].z + v[q][j].w * v[q][j].w);
            const float wave_sum_s = wave_sum(s);
            if (lane == 0) *(f32x4*)((float*)(ws_ + WS_RS) + 4 * (size_t)m) = (f32x4){wave_sum_s, 0.f, 0.f, 0.f};
            u32x2* o8 = (u32x2*)((bf16*)(ws_ + WS_XN) + (size_t)m * D) + lane;
#pragma unroll
            for (int j = 0; j < 4; ++j) { u32x2 w; w.x = pk2(v[q][j].x, v[q][j].y); w.y = pk2(v[q][j].z, v[q][j].w); o8[64 * j] = w; } } }
    }
    for (int mm = gw; mm < DEPTH * MMEM; mm += NGW) { const int l = mm / MMEM, r = mm % MMEM;
        rms_row_to_bf16(KIN(1) + (size_t)r * D, KIN(18) + (size_t)l * D, (bf16*)(ws_ + WS_MN + (size_t)l * MiB) + (size_t)r * D, lane); }
    { const int gt = gw * 64 + lane, NGT = NGW * 64;
      for (int i = gt; i < DEPTH * 4 * 128 * 128 / 8; i += NGT) {
          const int e0 = i * 8, s0 = e0 & 127, t = (e0 >> 7) & 127;
          const f32x4 a0 = *(const f32x4*)(KIN(9) + e0), a1 = *(const f32x4*)(KIN(9) + e0 + 4);
          float v[8] = {a0.x, a0.y, a0.z, a0.w, a1.x, a1.y, a1.z, a1.w};
#pragma unroll
          for (int e = 0; e < 8; ++e) v[e] = (s0 + e <= t) ? v[e] : 0.f;
          u32x4 o; o.x = pk2(v[0], v[1]); o.y = pk2(v[2], v[3]); o.z = pk2(v[4], v[5]); o.w = pk2(v[6], v[7]);
          *(u32x4*)((bf16*)(ws_ + WS_SGW) + e0) = o; } }
}

__device__ __forceinline__ void resnorm_phase(bf16* XB, const bf16* Y, const float* g1, float* RS, float* outf, int gw, int NGW, int lane) {
    f32x4 gg[4];
#pragma unroll
    for (int j = 0; j < 4; ++j) gg[j] = ((const f32x4*)g1)[lane + 64 * j];
    for (int m0 = gw; m0 < M; m0 += 2 * NGW) {
        u32x2 yw[2][4], xw[2][4];
#pragma unroll
        for (int q = 0; q < 2; ++q) { const int m = m0 + q * NGW; if (m < M) {
            const u32x2* yr = (const u32x2*)(Y + (size_t)m * D) + lane; const u32x2* xr = (const u32x2*)(XB + (size_t)m * D) + lane;
#pragma unroll
            for (int j = 0; j < 4; ++j) { yw[q][j] = yr[64 * j]; xw[q][j] = xr[64 * j]; } } }
#pragma unroll
        for (int q = 0; q < 2; ++q) { const int m = m0 + q * NGW; if (m < M) {
            f32x4 yv[4]; float ss = 0.f;
#pragma unroll
            for (int j = 0; j < 4; ++j) { const u32x2 w = yw[q][j]; yv[j] = (f32x4){bflo(w.x), bfhi(w.x), bflo(w.y), bfhi(w.y)};
                ss += (yv[j].x * yv[j].x + yv[j].y * yv[j].y) + (yv[j].z * yv[j].z + yv[j].w * yv[j].w); }
            const float r1 = fast_rsq(wave_sum(ss) * (1.f / D) + EPS);
            float s2 = 0.f; f32x4 xv[4];
#pragma unroll
            for (int j = 0; j < 4; ++j) { const u32x2 w = xw[q][j]; xv[j] = (f32x4){bflo(w.x), bfhi(w.x), bflo(w.y), bfhi(w.y)} + yv[j] * r1 * gg[j];
                s2 += (xv[j].x * xv[j].x + xv[j].y * xv[j].y) + (xv[j].z * xv[j].z + xv[j].w * xv[j].w); }
            if (outf) { f32x4* xo = (f32x4*)(outf + (size_t)m * D) + lane;
#pragma unroll
                for (int j = 0; j < 4; ++j) xo[64 * j] = xv[j];
            } else {
                const float r2 = fast_rsq(wave_sum(s2) * (1.f / D) + EPS);
                if (lane == 0) RS[m] = r2;
                u32x2* o8 = (u32x2*)(XB + (size_t)m * D) + lane;
#pragma unroll
                for (int j = 0; j < 4; ++j) { u32x2 w; w.x = pk2(xv[j].x, xv[j].y); w.y = pk2(xv[j].z, xv[j].w); o8[64 * j] = w; }
            } } }
    }
}

struct MixP { const bf16* Z; bf16* YC; const float *pool_w, *pool_scale, *sg_ln_g, *sg_ln_b, *sg_b, *conv_w, *conv_b, *conv_ln_g, *conv_ln_b; const bf16* SGW; };

constexpr int MX_H = 0, MX_AT = 0, MX_PWT = 0, MX_P = 73728, MX_VT = 0, MX_LNT = 106496;
constexpr int PWT_LD = 72, P_LD = 264, VT_LD = 136;

__device__ __forceinline__ void mixer_unit(LAS unsigned char* lds, const MixP& p, int unit, const int wave) {
    const int t0 = unit * 128, s0 = t0 % SEQ;
    const bf16* Zb = p.Z + (size_t)t0 * D_IN;
    bf16* Yb = p.YC + (size_t)t0 * D;
    typedef float f32x2 __attribute__((ext_vector_type(2)));
#ifndef SKIP_CONV
    for (int repc = 0; repc < REP_MIXC; ++repc) {
        const int tid = mk_tid(wave), lane = tid & 63;
        LAS bf16* H = (LAS bf16*)(lds + MX_H);
#pragma unroll 1
        for (int bb = 0; bb < 2; ++bb) {
            u32x4 av[8], gv[8];
#pragma unroll
            for (int j = 0; j < 8; ++j) {
                const int idx = (bb * 8 + j) * NTHREADS + tid, r = idx / 48, vv = idx - r * 48, srel = r - 30;
                av[j] = (u32x4){0u, 0u, 0u, 0u}; gv[j] = av[j];
                if (idx < 158 * 48 && s0 + srel >= 0) { const bf16* zr = Zb + (ptrdiff_t)srel * D_IN + ZC_OFF + 8 * vv; av[j] = *(const u32x4*)zr; gv[j] = *(const u32x4*)(zr + W_C); }
            }
#pragma unroll
            for (int j = 0; j < 8; ++j) {
                const int idx = (bb * 8 + j) * NTHREADS + tid, r = idx / 48, vv = idx - r * 48;
                u32x4 o;
                o.x = pk2(bflo(av[j].x) * sigmoidf_(bflo(gv[j].x)), bfhi(av[j].x) * sigmoidf_(bfhi(gv[j].x)));
                o.y = pk2(bflo(av[j].y) * sigmoidf_(bflo(gv[j].y)), bfhi(av[j].y) * sigmoidf_(bfhi(gv[j].y)));
                o.z = pk2(bflo(av[j].z) * sigmoidf_(bflo(gv[j].z)), bfhi(av[j].z) * sigmoidf_(bfhi(gv[j].z)));
                o.w = pk2(bflo(av[j].w) * sigmoidf_(bflo(gv[j].w)), bfhi(av[j].w) * sigmoidf_(bfhi(gv[j].w)));
                if (idx < 158 * 48) *(LAS u32x4*)(H + r * W_C + 8 * vv) = o;
            }
        }
        __syncthreads();
        {
            const int tok0 = wave * 16;
            f32x2 acc[3][16];
#pragma unroll
            for (int ch = 0; ch < 3; ++ch) {
                int ln = lane; asm volatile("" : "+v"(ln));
                const int c = ch * 128 + 2 * ln;
                f32x2 w[CONV_K];
#pragma unroll
                for (int k = 0; k < CONV_K; ++k) w[k] = *(const f32x2*)(p.conv_w + k * W_C + c);
                const f32x2 cb = *(const f32x2*)(p.conv_b + c);
#pragma unroll
                for (int j = 0; j < 16; ++j) acc[ch][j] = cb;
                const LAS bf16* hp = H + tok0 * W_C + c;
#pragma unroll
                for (int q = 0; q < 46; ++q) {
                    const unsigned hw = *(const LAS unsigned*)(hp + q * W_C);
                    const f32x2 h2 = {bflo(hw), bfhi(hw)};
#pragma unroll
                    for (int j = 0; j < 16; ++j) { if (q - j >= 0 && q - j < CONV_K) acc[ch][j] = acc[ch][j] + h2 * w[q - j]; }
                }
                asm volatile("" ::: "memory");
            }
            float v[32];
#pragma unroll
            for (int j = 0; j < 16; ++j) {
                float s1 = 0.f, s2 = 0.f;
#pragma unroll
                for (int ch = 0; ch < 3; ++ch) { s1 += acc[ch][j].x + acc[ch][j].y; s2 += acc[ch][j].x * acc[ch][j].x + acc[ch][j].y * acc[ch][j].y; }
                v[j] = s1; v[16 + j] = s2;
            }
#pragma unroll
            for (int step = 0; step < 5; ++step) {
                const int half = 16 >> step, mask = 32 >> step;
                const bool b = (lane & mask) != 0;
#pragma unroll
                for (int jj = 0; jj < half; ++jj) {
                    const float send = b ? v[jj] : v[half + jj], keep = b ? v[half + jj] : v[jj];
                    v[jj] = keep + __shfl_xor(send, mask);
                }
            }
            const float vt = v[0] + __shfl_xor(v[0], 1);
            int ln = lane; asm volatile("" : "+v"(ln));
            f32x2 lgv[3], lbv[3];
#pragma unroll
            for (int ch = 0; ch < 3; ++ch) { lgv[ch] = *(const f32x2*)(p.conv_ln_g + ch * 128 + 2 * ln); lbv[ch] = *(const f32x2*)(p.conv_ln_b + ch * 128 + 2 * ln); }
#pragma unroll
            for (int j = 0; j < 16; ++j) {
                const float S1 = __int_as_float(__builtin_amdgcn_readlane(__float_as_int(vt), 2 * j));
                const float S2 = __int_as_float(__builtin_amdgcn_readlane(__float_as_int(vt), 32 + 2 * j));
                const float mean = S1 * (1.f / W_C);
                const float var = S2 * (1.f / W_C) - mean * mean;
                const float rstd = fast_rsq(fmaxf(var, 0.f) + EPS);
                bf16* yr = Yb + (size_t)(tok0 + j) * D + W_A + W_B;
#pragma unroll
                for (int ch = 0; ch < 3; ++ch) {
                    const int c = ch * 128 + 2 * ln;
                    const f32x2 lg = lgv[ch], lb = lbv[ch];
                    const float y0 = (acc[ch][j].x - mean) * rstd * lg.x + lb.x, y1 = (acc[ch][j].y - mean) * rstd * lg.y + lb.y;
                    *(unsigned*)(yr + c) = pk2(y0 * sigmoidf_(y0), y1 * sigmoidf_(y1));
                }
            }
        }
        __syncthreads();
    }
#endif
#ifndef SKIP_POOL
    for (int repa = 0; repa < REP_MIXA; ++repa) {
        const int tid = mk_tid(wave), lane = tid & 63;
        LAS bf16* PWt = (LAS bf16*)(lds + MX_PWT);
        LAS bf16* P = (LAS bf16*)(lds + MX_P);
        LAS bf16* AT = (LAS bf16*)(lds + MX_AT);
        {
            u32x4 tt[9];
#pragma unroll
            for (int j = 0; j < 9; ++j) { const int idx = j * NTHREADS + tid, r = idx >> 5, c16 = idx & 31, srel = r - 15;
                tt[j] = (u32x4){0u, 0u, 0u, 0u};
                if (idx < 143 * 32 && s0 + srel >= 0) tt[j] = *(const u32x4*)(Zb + (ptrdiff_t)srel * D_IN + c16 * 8); }
#pragma unroll
            for (int j = 0; j < 9; ++j) { const int idx = j * NTHREADS + tid, r = idx >> 5, c16 = idx & 31;
                if (idx < 143 * 32) *(LAS u32x4*)(AT + r * 256 + c16 * 8) = tt[j]; }
        }
        float pw[32];
#pragma unroll
        for (int i = 0; i < 32; ++i) pw[i] = p.pool_w[i * NTHREADS + tid];
        __syncthreads();
        {
            const int ch = tid & 255, th = tid >> 8, g = ch >> 6, w = 2 << g, tstart = th * 64;
            const LAS bf16* ac = AT + 15 * 256 + ch;
            float win = 0.f;
            for (int jj = 1; jj < w; ++jj) win += bf2f(ac[(tstart - jj) * 256]);
#pragma unroll 1
            for (int t8 = tstart; t8 < tstart + 64; t8 += 8) {
                float an[8], ao[8];
#pragma unroll
                for (int e = 0; e < 8; ++e) { an[e] = bf2f(ac[(t8 + e) * 256]); ao[e] = bf2f(ac[(t8 + e - w + 1) * 256]); }
#pragma unroll
                for (int e = 0; e < 8; ++e) {
                    win += an[e];
                    const int cnt = min(s0 + t8 + e + 1, w);
                    const float pv = win * fast_rcp((float)cnt) - an[e];
                    P[(t8 + e) * P_LD + ch] = (bf16)(pk2(pv, 0.f) & 0xffffu);
                    win -= ao[e];
                }
            }
        }
        __syncthreads();
#pragma unroll
        for (int i = 0; i < 32; ++i) { const int idx = i * NTHREADS + tid, g = idx >> 12, c = (idx >> 6) & 63, d = idx & 63;
            const int slot = (d & 32) + 16 * ((d >> 2) & 1) + 4 * ((d >> 3) & 3) + (d & 3);
            PWt[(g * 64 + slot) * PWT_LD + c] = (bf16)(pk2(pw[i], 0.f) & 0xffffu); }
        __syncthreads();
        const int fr = lane & 15, fq = lane >> 4;
#pragma unroll
        for (int g = 0; g < 4; ++g) {
            bf16x8 pf[2];
#pragma unroll
            for (int ks = 0; ks < 2; ++ks) pf[ks] = *(const LAS bf16x8*)(P + (wave * 16 + fr) * P_LD + g * 64 + ks * 32 + fq * 8);
#pragma unroll
            for (int gq = 0; gq < 2; ++gq) {
                f32x4 acc2[2];
#pragma unroll
                for (int th = 0; th < 2; ++th) {
                    f32x4 acc = {0.f, 0.f, 0.f, 0.f};
#pragma unroll
                    for (int ks = 0; ks < 2; ++ks) {
                        const bf16x8 wf = *(const LAS bf16x8*)(PWt + (g * 64 + gq * 32 + th * 16 + fr) * PWT_LD + ks * 32 + fq * 8);
                        acc = __builtin_amdgcn_mfma_f32_16x16x32_bf16(wf, pf[ks], acc, 0, 0, 0);
                    }
                    acc2[th] = acc;
                }
                const int col = g * 64 + gq * 32 + 8 * fq;
                const f32x4 sc0 = *(const f32x4*)(p.pool_scale + col), sc1 = *(const f32x4*)(p.pool_scale + col + 4);
                u32x4 o; o.x = pk2(acc2[0][0] * sc0.x, acc2[0][1] * sc0.y); o.y = pk2(acc2[0][2] * sc0.z, acc2[0][3] * sc0.w);
                o.z = pk2(acc2[1][0] * sc1.x, acc2[1][1] * sc1.y); o.w = pk2(acc2[1][2] * sc1.z, acc2[1][3] * sc1.w);
                *(u32x4*)(Yb + (size_t)(wave * 16 + fr) * D + col) = o;
            }
        }
        __syncthreads();
    }
#endif
#ifndef SKIP_GATE
    for (int repb = 0; repb < REP_MIXB; ++repb) {
        const int tid = mk_tid(wave), lane = tid & 63;
        LAS bf16* VT = (LAS bf16*)(lds + MX_VT);
        LAS f32x2* LNT = (LAS f32x2*)(lds + MX_LNT);
        if (tid < W_B) LNT[tid] = (f32x2){p.sg_ln_g[tid], p.sg_ln_b[tid]};
        {
            const int t = tid >> 2, part = tid & 3;
            const bf16* zr = Zb + (size_t)t * D_IN + ZV_OFF + part * 8;
            float v[96]; float s1 = 0.f, s2 = 0.f;
#pragma unroll
            for (int i = 0; i < 12; ++i) { const u32x4 w = *(const u32x4*)(zr + 32 * i);
                const unsigned ww[4] = {w.x, w.y, w.z, w.w};
#pragma unroll
                for (int e = 0; e < 4; ++e) { const float a = gelu_tanh(bflo(ww[e])), b = gelu_tanh(bfhi(ww[e])); v[8 * i + 2 * e] = a; v[8 * i + 2 * e + 1] = b; s1 += a + b; s2 += a * a + b * b; } }
            s1 += __shfl_xor(s1, 1); s2 += __shfl_xor(s2, 1); s1 += __shfl_xor(s1, 2); s2 += __shfl_xor(s2, 2);
            const float mean = s1 * (1.f / W_B), var = s2 * (1.f / W_B) - mean * mean, rstd = fast_rsq(fmaxf(var, 0.f) + EPS);
            __syncthreads();
#pragma unroll
            for (int j = 0; j < 96; ++j) { const int c = 8 * (4 * (j >> 3) + part) + (j & 7); const f32x2 gb = LNT[c]; const float y = (v[j] - mean) * rstd * gb.x + gb.y;
                const int slot = 32 * (j >> 3) + 16 * ((j >> 2) & 1) + 4 * part + (j & 3);
                VT[slot * VT_LD + t] = (bf16)(pk2(y, 0.f) & 0xffffu); }
        }
        const int tid2 = mk_tid(wave), lane2 = tid2 & 63;
        const int fr = lane2 & 15, fq = lane2 >> 4;
        const int nks = (wave >> 1) + 1;
        const int trow = wave * 16 + fr;
        bf16x8 wf[4][4]; u32x4 uz[4][3]; float sb[4];
#pragma unroll
        for (int h = 0; h < 4; ++h) {
#pragma unroll
            for (int ks = 0; ks < 4; ++ks) wf[h][ks] = (ks < nks) ? *(const bf16x8*)(p.SGW + ((size_t)(h * 128 + trow) * 128 + ks * 32 + fq * 8)) : (bf16x8){0, 0, 0, 0, 0, 0, 0, 0};
            sb[h] = p.sg_b[h * 128 + trow];
#pragma unroll
            for (int gq = 0; gq < 3; ++gq) uz[h][gq] = *(const u32x4*)(Zb + (size_t)trow * D_IN + ZB_OFF + h * 96 + gq * 32 + 8 * fq);
        }
        __syncthreads();
#pragma unroll
        for (int h = 0; h < 4; ++h) {
#pragma unroll
            for (int gq = 0; gq < 3; ++gq) {
                f32x4 acc2[2];
#pragma unroll
                for (int th = 0; th < 2; ++th) {
                    f32x4 acc = {0.f, 0.f, 0.f, 0.f};
#pragma unroll
                    for (int ks = 0; ks < 4; ++ks) {
                        if (ks < nks) {
                            const bf16x8 vf = *(const LAS bf16x8*)(VT + (h * 96 + gq * 32 + th * 16 + fr) * VT_LD + ks * 32 + fq * 8);
                            acc = __builtin_amdgcn_mfma_f32_16x16x32_bf16(vf, wf[h][ks], acc, 0, 0, 0);
                        }
                    }
                    acc2[th] = acc;
                }
                const u32x4 uw = uz[h][gq];
                const float u0 = gelu_tanh(bflo(uw.x)), u1 = gelu_tanh(bfhi(uw.x)), u2 = gelu_tanh(bflo(uw.y)), u3 = gelu_tanh(bfhi(uw.y));
                const float u4 = gelu_tanh(bflo(uw.z)), u5 = gelu_tanh(bfhi(uw.z)), u6 = gelu_tanh(bflo(uw.w)), u7 = gelu_tanh(bfhi(uw.w));
                u32x4 o; o.x = pk2(u0 * (acc2[0][0] + sb[h]), u1 * (acc2[0][1] + sb[h])); o.y = pk2(u2 * (acc2[0][2] + sb[h]), u3 * (acc2[0][3] + sb[h]));
                o.z = pk2(u4 * (acc2[1][0] + sb[h]), u5 * (acc2[1][1] + sb[h])); o.w = pk2(u6 * (acc2[1][2] + sb[h]), u7 * (acc2[1][3] + sb[h]));
                *(u32x4*)(Yb + (size_t)trow * D + W_A + h * 96 + gq * 32 + 8 * fq) = o;
            }
        }
        __syncthreads();
    }
#endif
}

constexpr int AT_LD = 528;
#define AT_STAGE_IDX const int tids = mk_tid(wave), t5 = tids >> 5, c16 = tids & 31;
#define AT_STAGE_IDX_W(w_) const int tids = mk_tid(w_), t5 = tids >> 5, c16 = tids & 31;
#define AT_KOFF const int pe = 16 * ((t5 >> 2) & 1) + 4 * (t5 >> 3) + (t5 & 3); const unsigned voe = (unsigned)(pe * D + c16 * 8), voo = (unsigned)((pe + 8) * D + c16 * 8);
__device__ __forceinline__ void attn_unit(LAS unsigned char* lds, const bf16* Vt, bf16* O, const int wave, const int h, const int q0, const int b, u32x4 (&st)[16], const bf16x8 (&qf)[16]) {
    const int tid = mk_tid(wave), lane = tid & 63, r32 = lane & 31, hi = lane >> 5;
    const LAS unsigned char* ka = lds + r32 * AT_LD + hi * 16;
    const LAS unsigned char* va = lds + r32 * AT_LD + hi * 32;
        __syncthreads();
        { AT_STAGE_IDX LAS unsigned char* lw = lds + t5 * AT_LD + c16 * 16;
#pragma unroll
          for (int i = 0; i < 16; ++i) *(LAS u32x4*)(lw + i * 16 * AT_LD) = st[i]; }
        __syncthreads();
        f32x16 S[8];
        {
            bf16x8 kf[2][4];
#pragma unroll
            for (int j = 0; j < 4; ++j) kf[0][j] = *(const LAS bf16x8*)(ka + j * 32);
#pragma unroll
            for (int mt = 0; mt < 8; ++mt) {
                f32x16 acc;
#pragma unroll
                for (int e = 0; e < 16; ++e) acc[e] = 0.f;
#pragma unroll
                for (int k4 = 0; k4 < 4; ++k4) {
                    const int g = mt * 4 + k4, gn = g + 1;
                    if (gn < 32) {
#pragma unroll
                        for (int j = 0; j < 4; ++j) kf[gn & 1][j] = *(const LAS bf16x8*)(ka + (gn >> 2) * 32 * AT_LD + ((gn & 3) * 4 + j) * 32);
                    }
                    __builtin_amdgcn_sched_barrier(0);
#pragma unroll
                    for (int j = 0; j < 4; ++j) acc = __builtin_amdgcn_mfma_f32_32x32x16_bf16(kf[g & 1][j], qf[k4 * 4 + j], acc, 0, 0, 0);
                    __builtin_amdgcn_sched_barrier(0);
                }
                S[mt] = acc;
            }
        }
        float mx = -3.0e38f;
#pragma unroll
        for (int mt = 0; mt < 8; ++mt)
#pragma unroll
            for (int e = 0; e < 16; ++e) mx = fmaxf(mx, S[mt][e]);
        mx = fmaxf(mx, __shfl_xor(mx, 32));
        float sum = 0.f;
        bf16x8 pf[8][2];
        const float mxl = mx * 1.4426950409f;
#pragma unroll
        for (int mt = 0; mt < 8; ++mt) {
#pragma unroll
            for (int e = 0; e < 16; ++e) { const float pe_ = __builtin_amdgcn_exp2f(S[mt][e] * 1.4426950409f - mxl); S[mt][e] = pe_; sum += pe_; }
#pragma unroll
            for (int hf = 0; hf < 2; ++hf) {
                u32x4 w; w.x = pk2(S[mt][8 * hf + 0], S[mt][8 * hf + 1]); w.y = pk2(S[mt][8 * hf + 2], S[mt][8 * hf + 3]);
                w.z = pk2(S[mt][8 * hf + 4], S[mt][8 * hf + 5]); w.w = pk2(S[mt][8 * hf + 6], S[mt][8 * hf + 7]);
                pf[mt][hf] = __builtin_bit_cast(bf16x8, w);
            }
        }
        sum += __shfl_xor(sum, 32);
        const float inv = fast_rcp(sum);
        {
            AT_STAGE_IDX const unsigned vo = (unsigned)(t5 * MMEM + c16 * 8);
            const bf16* vbase = Vt + (size_t)(h * 256) * MMEM + b * NMEM;
#pragma unroll
            for (int i = 0; i < 16; ++i) { const bf16* vb_i = vbase + (size_t)i * 16 * MMEM; st[i] = *(const u32x4*)(vb_i + vo); }
        }
        __syncthreads();
        { AT_STAGE_IDX LAS unsigned char* lw = lds + t5 * AT_LD + c16 * 16;
#pragma unroll
          for (int i = 0; i < 16; ++i) *(LAS u32x4*)(lw + i * 16 * AT_LD) = st[i]; }
        __syncthreads();
        bf16* op = O + (size_t)(q0 + r32) * D + h * 256;
        {
            bf16x8 vf[2][4];
#pragma unroll
            for (int j = 0; j < 4; ++j) vf[0][j] = *(const LAS bf16x8*)(va + ((j >> 1) * 32 + 8 * (j & 1)) * 2);
#pragma unroll
            for (int dt = 0; dt < 8; ++dt) {
                f32x16 acc;
#pragma unroll
                for (int e = 0; e < 16; ++e) acc[e] = 0.f;
#pragma unroll
                for (int q4 = 0; q4 < 4; ++q4) {
                    const int g = dt * 4 + q4, gn = g + 1;
                    if (gn < 32) {
#pragma unroll
                        for (int j = 0; j < 4; ++j) vf[gn & 1][j] = *(const LAS bf16x8*)(va + (gn >> 2) * 32 * AT_LD + (((gn & 3) * 2 + (j >> 1)) * 32 + 8 * (j & 1)) * 2);
                    }
                    __builtin_amdgcn_sched_barrier(0);
#pragma unroll
                    for (int j = 0; j < 4; ++j) acc = __builtin_amdgcn_mfma_f32_32x32x16_bf16(vf[g & 1][j], pf[q4 * 2 + (j >> 1)][j & 1], acc, 0, 0, 0);
                    __builtin_amdgcn_sched_barrier(0);
                }
                u32x2 o[4];
#pragma unroll
                for (int j = 0; j < 4; ++j) { o[j].x = pk2(acc[4 * j] * inv, acc[4 * j + 1] * inv); o[j].y = pk2(acc[4 * j + 2] * inv, acc[4 * j + 3] * inv); }
#pragma unroll
                for (int pr = 0; pr < 2; ++pr) {
                    const auto rx = __builtin_amdgcn_permlane32_swap(o[2 * pr].x, o[2 * pr + 1].x, false, false);
                    const auto ry = __builtin_amdgcn_permlane32_swap(o[2 * pr].y, o[2 * pr + 1].y, false, false);
                    const u32x4 w = {rx[0], ry[0], rx[1], ry[1]};
                    *(u32x4*)(op + dt * 32 + 8 * (2 * pr + hi)) = w; }
            }
        }
    __syncthreads();
}

constexpr int TB_Q_OFF = 139264;
struct EpiQ {
    static constexpr bool PERM = true, AFTER_DRAIN = true;
    float scale; const bf16* Kb; const bf16* Vt; bf16* O; int pm_off; int wave0;
    __device__ __forceinline__ void fused(pg8::f32x4 (&acc)[2][2][4][2], const pg8::Unit& u, int wr, int wc, int fr, int fq, LAS unsigned char* lds, int wid, int lane) const {
        const int pmg = __builtin_amdgcn_readfirstlane(u.pm + pm_off), h = __builtin_amdgcn_readfirstlane(u.pn), b = (pmg * 256) / SEQ, q0 = pmg * 256 + wave0 * 32;
        u32x4 st[16];
        const LAS float* tb = (const LAS float*)(lds + TB_Q_OFF);
#pragma unroll
        for (int ai = 0; ai < 2; ++ai)
#pragma unroll
            for (int m = 0; m < 4; ++m) { const int row = ai * 128 + wr * 64 + m * 16 + fr; const float rsv = tb[row] * scale;
#pragma unroll
                for (int bj = 0; bj < 2; ++bj) { const pg8::f32x4 v0 = acc[ai][bj][m][0] * rsv, v1 = acc[ai][bj][m][1] * rsv;
                    u32x4 w; w.x = pk2(v0[0], v0[1]); w.y = pk2(v0[2], v0[3]); w.z = pk2(v1[0], v1[1]); w.w = pk2(v1[2], v1[3]);
                    *(LAS u32x4*)(lds + row * AT_LD + (bj * 128 + wc * 32 + 8 * fq) * 2) = w; } }
        {
            AT_STAGE_IDX_W(wave0) AT_KOFF
            const bf16* kbase = Kb + (size_t)(b * NMEM) * D + h * 256;
#pragma unroll
            for (int i = 0; i < 16; ++i) { const bf16* kb_i = kbase + (size_t)(i >> 1) * 32 * D; st[i] = *(const u32x4*)(kb_i + ((i & 1) ? voo : voe)); }
        }
        __syncthreads();
        bf16x8 qf[16];
        { const int r32 = lane & 31, hi = lane >> 5; const LAS unsigned char* qp = lds + (wave0 * 32 + r32) * AT_LD + hi * 16;
#pragma unroll
          for (int ks = 0; ks < 16; ++ks) qf[ks] = *(const LAS bf16x8*)(qp + ks * 32); }
        LDS_WAIT();
        attn_unit(lds, Vt, O, wave0, h, q0, b, st, qf);
    }
};
__device__ __forceinline__ void run_gemm_qattn(LAS unsigned char* lds, const bf16* A, const bf16* Bt, const float* rs, const bf16* Kb, const bf16* Vt, bf16* O, int G, int c, const int wave0) {
#pragma unroll 1
    for (int half = 0; half < 2; ++half) {
        const int tid = mk_tid(wave0);
        pg8::Gemm g{A + (size_t)half * (M / 2) * D, Bt, M / 2, D, D}; pg8::StaticOrder S; S.init(M / 2, D, G, c); S.wgm = WGM_Q;
        { pg8::Unit u; if (S.next(0, u) && tid < 256) { const f32x4 s4 = *(const f32x4*)(rs + 4 * (size_t)((u.pm + half * (M / 2 / 256)) * 256 + tid));
            ((LAS float*)(lds + TB_Q_OFF))[tid] = fast_rsq(((s4[0] + s4[1]) + (s4[2] + s4[3])) * (1.0f / 1024.0f) + EPS); } }
        __syncthreads();
        EpiQ E{0.0625f, Kb, Vt, O, half * (M / 2 / 256), wave0};
        pg8::gemm_phase<EpiQ, pg8::StaticOrder, false, true>(lds, g, S, E, tid);
    }
}

constexpr int TB_RS_OFF = 131072, TB_BIAS_OFF = 131072 + 8192;
__device__ __forceinline__ void run_gemm(LAS unsigned char* lds, const bf16* A, const bf16* Bt, int m, int n, int k, bf16* O, int ldc, const float* bias, const float* rs, float scale, int act, int G, int c, int tid) {
    pg8::Gemm g{A, Bt, m, n, k}; pg8::StaticOrder S; S.init(m, n, G, c); S.wgm = (n == FF) ? WGM_FF1 : ((n == D_IN) ? WGM_IN : 8);
    LAS float* tb_rs = (LAS float*)(lds + TB_RS_OFF); LAS float* tb_bias = (LAS float*)(lds + TB_BIAS_OFF);
    if (rs || bias) {
        pg8::Unit u;
        for (int i = 0; i < 8 && S.next(i, u); ++i) {
            if (tid < 256) { if (rs) { const f32x4 s4 = *(const f32x4*)(rs + 4 * (size_t)(u.pm * 256 + tid)); tb_rs[i * 256 + tid] = fast_rsq(((s4[0] + s4[1]) + (s4[2] + s4[3])) * (1.0f / 1024.0f) + EPS); } }
            else if (bias && i < 4) tb_bias[i * 256 + (tid - 256)] = bias[u.pn * 256 + (tid - 256)];
        }
        __syncthreads();
    }
    pg8::EpiGen E{O, ldc, bias ? tb_bias : nullptr, rs ? tb_rs : nullptr, scale, act, 0};
    pg8::gemm_phase<pg8::EpiGen, pg8::StaticOrder, true, true>(lds, g, S, E, tid);
}

__device__ __forceinline__ void run_gemm_fused(LAS unsigned char* lds, const bf16* A, const bf16* Bt, int k, bf16* XB, float* outf, const float* g1, float* SS2, unsigned* xbuf, unsigned* cnt, int G, int c, const int wave0) {
#pragma unroll 1
    for (int half = 0; half < 2; ++half) {
        const int tid = mk_tid(wave0);
        pg8::Gemm g{A + (size_t)half * (M / 2) * k, Bt, M / 2, D, k}; pg8::StaticOrder S; S.init(M / 2, D, G, c); S.wgm = WGM_FZ;
        pg8::EpiResNorm E{XB, outf, g1, SS2, half * (M / 2 / 256), xbuf, cnt};
        pg8::gemm_phase<pg8::EpiResNorm, pg8::StaticOrder, false, true>(lds, g, S, E, tid);
    }
}

__global__ void __launch_bounds__(NTHREADS, 2) fwd_megakernel(Args a) {
    extern __shared__ __attribute__((aligned(16))) unsigned char lds_raw[];
    LAS unsigned char* lds = (LAS unsigned char*)lds_raw;
    cg::grid_group grid = cg::this_grid();
    if (a.ph_lo < 0) grid.sync();
    const int wave0 = __builtin_amdgcn_readfirstlane(threadIdx.x >> 6);
    { LAS unsigned* misc = (LAS unsigned*)(lds + MISC_OFF); const int t_ = mk_tid(wave0); if (t_ < 16) misc[t_] = 0u; }
    __syncthreads();
    const XcdBarrier xbar = xcd_barrier_post((unsigned*)(a.ws + WS_CTL) + CW_BAR, (volatile LAS unsigned*)(lds + MISC_OFF) + 8, mk_tid(wave0) == 0);
    const AS4 unsigned char* kargs = (const AS4 unsigned char*)__builtin_amdgcn_kernarg_segment_ptr();
    const int G = gridDim.x, bx = blockIdx.x;
    const int NGW = G * NWAVES;
    unsigned char* ws = a.ws;
    bf16* XN = (bf16*)(ws + WS_XN); bf16* Y = (bf16*)(ws + WS_Y); bf16* Z = (bf16*)(ws + WS_Z); bf16* BUFA = (bf16*)(ws + WS_BUFA); bf16* F = (bf16*)(ws + WS_F); float* RS = (float*)(ws + WS_RS);

#pragma unroll 1
    for (int ph = a.ph_lo; ph < a.ph_hi; ++ph) {
        if (ph > a.ph_lo) { for (int rep = 0; rep < REP_SYNC; ++rep) { xcd_barrier(xbar, mk_tid(wave0) == 0); } }
        int kz = 0; asm volatile("" : "+s"(kz));
        const int tid = mk_tid(wave0);
        const int lane = tid & 63, wave = wave0;
        const int gw = bx * NWAVES + wave;
        if (ph == 0) { for (int rep = 0; rep < REP_P0; ++rep) { p0_prologue(kargs, kz, ws, lds, gw, NGW, wave, lane); __syncthreads(); } continue; }
        bool is_gemm = false;
        const bf16* gA = nullptr; const bf16* gB = nullptr; int gm = 0, gn = 0, gk = 0; bf16* gO = nullptr; int gld = 0; const float* gbias = nullptr; const float* grs = nullptr; float gscale = 1.f; int gact = 0, gG = G, gc = bx;
        const int l = (ph - 1) / 7, sub = (ph - 1) % 7;
        const unsigned char* wb = ws + WS_W + (size_t)l * WS_WL;
        const float* fz_g = nullptr; int fz_bank = 0; float* fz_out = nullptr;
        switch (sub) {
        case 0: is_gemm = true; gA = XN; gB = (const bf16*)(wb + WO_IN); gm = M; gn = D_IN; gk = D; gO = Z; gld = D_IN; gbias = KIN(4) + (size_t)l * D_IN; grs = RS; break;
        case 1: {
            MixP p; p.Z = Z; p.YC = BUFA; p.pool_w = KIN(5) + (size_t)l * 4 * 64 * 64; p.pool_scale = KIN(6) + (size_t)l * W_A;
            p.sg_ln_g = KIN(7) + (size_t)l * W_B; p.sg_ln_b = KIN(8) + (size_t)l * W_B; p.sg_b = KIN(10) + (size_t)l * 4 * 128;
            p.conv_w = KIN(11) + (size_t)l * CONV_K * W_C; p.conv_b = KIN(12) + (size_t)l * W_C; p.conv_ln_g = KIN(13) + (size_t)l * W_C; p.conv_ln_b = KIN(14) + (size_t)l * W_C;
            p.SGW = (const bf16*)(ws + WS_SGW) + (size_t)l * 4 * 128 * 128;
            for (int rep = 0; rep < REP_MIX; ++rep) for (int u = bx; u < M / 128; u += G) mixer_unit(lds, p, u, wave0);
        } break;
        case 2: gA = BUFA; gB = (const bf16*)(wb + WO_OUT); gk = D; fz_g = KIN(16) + (size_t)l * D; fz_bank = l * 3 + 0; break;
        case 3: run_gemm_qattn(lds, XN, (const bf16*)(wb + WO_Q), RS, (const bf16*)(ws + WS_KB + (size_t)l * MiB), (const bf16*)(ws + WS_VT + (size_t)l * MiB), Z, G, bx, wave0); break;
        case 4: gA = Z; gB = (const bf16*)(wb + WO_O); gk = D; fz_g = KIN(23) + (size_t)l * D; fz_bank = l * 3 + 1; break;
        case 5: is_gemm = true; gA = XN; gB = (const bf16*)(wb + WO_1); gm = M; gn = FF; gk = D; gO = F; gld = FF; gact = 1; grs = RS; break;
        case 6: gA = F; gB = (const bf16*)(wb + WO_2); gk = FF; fz_g = KIN(27) + (size_t)l * D; fz_bank = l * 3 + 2; fz_out = (l + 1 < DEPTH) ? nullptr : KOUT; break;
        default: break;
        }
        if (fz_g) run_gemm_fused(lds, gA, gB, gk, XN, fz_out, fz_g, RS, (unsigned*)(ws + WS_XBUF) + (size_t)fz_bank * M * 4, (unsigned*)(ws + WS_CTL) + CW_SEAM + fz_bank * SEAM_BANK, G, bx, wave0);
#ifndef SKIP_GEMM
        const int npass = (ph == 1) ? 2 : 1;
#pragma unroll 1
        for (int pass = 0; pass < npass; ++pass) {
            if (pass == 1) {
                const int cb = bx - (G >= 256 ? 128 : 0);
                const int gi = (cb >> 3) & 3, kl = gi >> 1, isv = gi & 1;
                const bf16* mn = (const bf16*)(ws + WS_MN + (size_t)kl * MiB);
                const unsigned char* kwb = ws + WS_W + (size_t)kl * WS_WL;
                gk = D; gG = 8; gc = (cb >= 0 && cb < 32) ? (cb & 7) : (1 << 24); gbias = nullptr; grs = nullptr; gscale = 1.f; gact = 0;
                if (isv) { gA = (const bf16*)(kwb + WO_V); gB = mn; gm = D; gn = MMEM; gO = (bf16*)(ws + WS_VT + (size_t)kl * MiB); gld = MMEM; }
                else     { gA = mn; gB = (const bf16*)(kwb + WO_K); gm = MMEM; gn = D; gO = (bf16*)(ws + WS_KB + (size_t)kl * MiB); gld = D; }
            }
            if (is_gemm) for (int rep = 0; rep < REP_GEMM; ++rep) run_gemm(lds, gA, gB, gm, gn, gk, gO, gld, gbias, grs, gscale, gact, gG, gc, mk_tid(wave0));
        }
#endif
    }
}

extern "C" void kernel_launch(void* const* d_in, const int* in_sizes, int n_in, void* d_out, int out_size, void* d_ws, size_t ws_size, hipStream_t stream) {
    static int grid = 0;
    if (grid == 0) {
        if (n_in != 28 || in_sizes[0] != M * D || out_size != M * D || ws_size < WS_END) { fprintf(stderr, "kernel_launch: unexpected shapes (n_in %d, in0 %d, out %d, ws %zu)\n", n_in, n_in > 0 ? in_sizes[0] : -1, out_size, ws_size); grid = -1; return; }
        int dev = 0, cus = 0, per_cu = 0;
        hipGetDevice(&dev);
        hipDeviceGetAttribute(&cus, hipDeviceAttributeMultiprocessorCount, dev);
        if (hipFuncSetAttribute((const void*)fwd_megakernel, hipFuncAttributeMaxDynamicSharedMemorySize, LDS_BYTES) != hipSuccess) { fprintf(stderr, "kernel_launch: hipFuncSetAttribute failed\n"); grid = -1; return; }
        if (hipOccupancyMaxActiveBlocksPerMultiprocessor(&per_cu, (const void*)fwd_megakernel, NTHREADS, LDS_BYTES) != hipSuccess || per_cu < 1) { fprintf(stderr, "kernel_launch: occupancy query says %d\n", per_cu); per_cu = 1; }
        (void)hipGetLastError();
        grid = cus * 1;
        if (grid != 256) fprintf(stderr, "kernel_launch: %d workgroups; the fused residual+norm epilogues need exactly 256 (one 256x256 unit per workgroup)\n", grid);
        fprintf(stderr, "kernel_launch: grid %d (cus %d, per_cu %d)\n", grid, cus, per_cu);
    }
    if (grid < 0) return;
    Args a{};
    for (int i = 0; i < 28; ++i) a.in[i] = (const float*)d_in[i];
    a.out = (float*)d_out; a.ws = (unsigned char*)d_ws;
#if MK_N_LAUNCHES == 1
    if (hipMemsetAsync((char*)d_ws + WS_CTL, 0, CTL_ZERO_BYTES, stream) != hipSuccess) { fprintf(stderr, "kernel_launch: memset failed\n"); return; }
    a.ph_lo = 0; a.ph_hi = NPH;
    void* args[] = {&a};
    hipError_t e = hipLaunchCooperativeKernel((const void*)fwd_megakernel, dim3(grid), dim3(NTHREADS), args, LDS_BYTES, stream);
    if (e != hipSuccess) fprintf(stderr, "kernel_launch: cooperative launch failed: %s (grid %d)\n", hipGetErrorString(e), grid);
#else
    for (int ph = 0; ph < NPH; ++ph) {
        a.ph_lo = ph; a.ph_hi = ph + 1;
        hipLaunchKernelGGL(fwd_megakernel, dim3(grid), dim3(NTHREADS), LDS_BYTES, stream, a);
    }
#endif
}
```

```cpp
#include <hip/hip_runtime.h>
#include <hip/hip_cooperative_groups.h>
#include <cstdio>
#include <cstdint>
namespace cg = cooperative_groups;
namespace pg8 {
#define PG8_LAS __attribute__((address_space(3)))
typedef unsigned short bf16_t;
typedef short bf16x8 __attribute__((ext_vector_type(8)));
typedef float f32x4 __attribute__((ext_vector_type(4)));
typedef unsigned u32x4 __attribute__((ext_vector_type(4)));
constexpr int BM = 256, BK = 64, HALF = 128, HTB = HALF * BK * 2  , STAGE_BYTES = 8 * HTB, NXCD = 8, WGM = 8;

__host__ __device__ __forceinline__ int lds_byte(int r, int c) { const int st = (r >> 4) * 2 + (c >> 5), rr = r & 15, cc = c & 31, ob = rr * 64 + cc * 2; return st * 1024 + (ob ^ (((ob >> 9) & 1) << 5)); }
__host__ __device__ __forceinline__ void stage_rc(int b, int& R, int& C) { const int st = b / 1024, sb = b % 1024, swz = sb ^ (((sb >> 9) & 1) << 5); R = (st >> 1) * 16 + swz / 64; C = (st & 1) * 32 + (swz % 64) / 2; }
__host__ __device__ __forceinline__ int perm32(int rho) { const int n = rho >> 4, i = rho & 15; return 8 * (i >> 2) + 4 * n + (i & 3); }

struct Unit { int pm, pn; };
struct Gemm { const bf16_t* A; const bf16_t* Bt; int M, N, K; };

struct StaticOrder {
    int nM, nN, nwg, G, c; int wgm = WGM;
    __host__ __device__ void init(int M, int N, int G_, int c_) { nM = M / BM; nN = N / BM; nwg = nM * nN; G = G_; c = c_; }
    __host__ __device__ bool next(int i, Unit& u) const {
        const long L = (long)i * G + c; if (L >= nwg) return false;
        int wgid = (int)L; { const int q = nwg / NXCD, r = nwg % NXCD, xcd = wgid % NXCD, off = wgid / NXCD; wgid = (xcd < r ? xcd * (q + 1) : r * (q + 1) + (xcd - r) * q) + off; }
        const int nig = wgm * nN, gid = wgid / nig, fm = gid * wgm, gsz = (nM - fm) < wgm ? (nM - fm) : wgm;
        u.pm = fm + ((wgid % nig) % gsz); u.pn = (wgid % nig) / gsz; return true;
    }
    __device__ __forceinline__ void a_ready(const Unit&) const {}
    __device__ __forceinline__ void done(const Unit&) const {}
};

__device__ __forceinline__ unsigned cvt_pk_bf16(float lo, float hi) { unsigned r; asm volatile("v_cvt_pk_bf16_f32 %0, %1, %2" : "=v"(r) : "v"(lo), "v"(hi)); return r; }
typedef float f32x2 __attribute__((ext_vector_type(2)));
__device__ __forceinline__ f32x2 gelu_pk(f32x2 v) {
    const f32x2 av = __builtin_elementwise_abs(v), d = av * 0.2316418882f + 1.0f;
    f32x2 t; t.x = __builtin_amdgcn_rcpf(d.x); t.y = __builtin_amdgcn_rcpf(d.y);
    f32x2 q = t * 0.5307027145f + (-0.7265760135f); q = q * t + 0.7107068705f; q = q * t + (-0.142248368f); q = q * t + 0.127414796f; q = q * t;
    const f32x2 s = (v * v) * (-0.72134752044f);
    f32x2 e; e.x = __builtin_amdgcn_exp2f(s.x); e.y = __builtin_amdgcn_exp2f(s.y);
    const f32x2 m = v * (q * e), r = v - m;
    f32x2 o; o.x = v.x < 0.f ? m.x : r.x; o.y = v.y < 0.f ? m.y : r.y; return o;
}

template <int ACT  > struct EpiBf16 {
    static constexpr bool PERM = true, AFTER_DRAIN = false; static_assert(ACT == 0 || ACT == 1, "EpiBf16: ACT is 0 (none) or 1 (gelu_pk)");
    bf16_t* O; int ldc; const float* bias; int split_cols; size_t split_stride; float scale0;
    __device__ __forceinline__ void operator()(const f32x4 (&acc)[2][2][4][2], const Unit& u, int wr, int wc, int fr, int fq) const {
        const int row0 = u.pm * BM + wr * 64 + fr; int colt = u.pn * BM; bf16_t* base = O;
        float sc = 1.f; if (split_cols) { const int t = colt / split_cols; base += (size_t)t * split_stride; colt -= t * split_cols; if (t == 0) sc = scale0; }
        const int col0 = colt + wc * 32 + 8 * fq, bcol0 = u.pn * BM + wc * 32 + 8 * fq;
        f32x4 bv[2][2];
#pragma unroll
        for (int bj = 0; bj < 2; ++bj)
#pragma unroll
            for (int n = 0; n < 2; ++n) bv[bj][n] = bias ? *(const f32x4*)(bias + bcol0 + bj * HALF + 4 * n) : (f32x4){0.f, 0.f, 0.f, 0.f};
#pragma unroll
        for (int ai = 0; ai < 2; ++ai)
#pragma unroll
            for (int m = 0; m < 4; ++m) { bf16_t* rowp = base + (size_t)(row0 + ai * HALF + m * 16) * ldc + col0;
#pragma unroll
                for (int bj = 0; bj < 2; ++bj) { f32x4 v0 = acc[ai][bj][m][0] + bv[bj][0], v1 = acc[ai][bj][m][1] + bv[bj][1];
                    if (ACT == 1) { f32x2 a = gelu_pk((f32x2){v0[0], v0[1]}), b = gelu_pk((f32x2){v0[2], v0[3]}), c = gelu_pk((f32x2){v1[0], v1[1]}), d = gelu_pk((f32x2){v1[2], v1[3]});
                        v0 = (f32x4){a.x, a.y, b.x, b.y}; v1 = (f32x4){c.x, c.y, d.x, d.y}; }
                    v0 = v0 * sc; v1 = v1 * sc; u32x4 w; w.x = cvt_pk_bf16(v0[0], v0[1]); w.y = cvt_pk_bf16(v0[2], v0[3]); w.z = cvt_pk_bf16(v1[0], v1[1]); w.w = cvt_pk_bf16(v1[2], v1[3]);
                    *(u32x4*)(rowp + bj * HALF) = w; } }
    }
};


struct EpiGen {
    static constexpr bool PERM = true, AFTER_DRAIN = false;
    bf16_t* O; int ldc; const PG8_LAS float* tb_bias; const PG8_LAS float* tb_rs; float scale; int act; mutable int ord;
    __device__ __forceinline__ void operator()(const f32x4 (&acc)[2][2][4][2], const Unit& u, int wr, int wc, int fr, int fq) const {
        const int row0 = u.pm * BM + wr * 64 + fr;
        const int col0 = u.pn * BM + wc * 32 + 8 * fq;
        f32x4 bv[2][2];
#pragma unroll
        for (int bj = 0; bj < 2; ++bj)
#pragma unroll
            for (int n = 0; n < 2; ++n) bv[bj][n] = tb_bias ? *(const PG8_LAS f32x4*)(tb_bias + ord * 256 + wc * 32 + 8 * fq + bj * HALF + 4 * n) : (f32x4){0.f, 0.f, 0.f, 0.f};
        const float sc = scale;
#pragma unroll
        for (int ai = 0; ai < 2; ++ai)
#pragma unroll
            for (int m = 0; m < 4; ++m) { bf16_t* rowp = O + (size_t)(row0 + ai * HALF + m * 16) * ldc + col0; const float rsv = tb_rs ? tb_rs[ord * 256 + wr * 64 + fr + ai * HALF + m * 16] : 1.f;
#pragma unroll
                for (int bj = 0; bj < 2; ++bj) { f32x4 v0 = acc[ai][bj][m][0] * rsv + bv[bj][0], v1 = acc[ai][bj][m][1] * rsv + bv[bj][1];
                    if (act) {
#pragma unroll
                        for (int e = 0; e < 4; ++e) { const float a0 = fmaxf(v0[e], 0.f), a1 = fmaxf(v1[e], 0.f); v0[e] = a0 * a0; v1[e] = a1 * a1; }
                    }
                    v0 = v0 * sc; v1 = v1 * sc; u32x4 w; w.x = cvt_pk_bf16(v0[0], v0[1]); w.y = cvt_pk_bf16(v0[2], v0[3]); w.z = cvt_pk_bf16(v1[0], v1[1]); w.w = cvt_pk_bf16(v1[2], v1[3]);
                    *(u32x4*)(rowp + bj * HALF) = w; } }
        ++ord;
    }
};


typedef unsigned u32x2 __attribute__((ext_vector_type(2)));
struct EpiResNorm {
    static constexpr bool PERM = true, AFTER_DRAIN = true;
    bf16_t* XB; float* outf; const float* g1; float* SS2; int pm_off; unsigned* xbuf; unsigned* cnt;
    __device__ __forceinline__ void fused(f32x4 (&acc)[2][2][4][2], const Unit& u, int wr, int wc, int fr, int fq, PG8_LAS unsigned char* lds, int wid, int lane) const {
        typedef __attribute__((address_space(1))) unsigned gu32_t;
        PG8_LAS float* P = (PG8_LAS float*)lds;
        PG8_LAS float* S = (PG8_LAS float*)(lds + 4096);
        const int pmg = u.pm + pm_off;
        const int col0 = u.pn * BM + wc * 32 + 8 * fq;
        u32x4 xw[2][4][2];
#pragma unroll
        for (int ai = 0; ai < 2; ++ai)
#pragma unroll
            for (int m = 0; m < 4; ++m) { const size_t off = (size_t)(pmg * BM + ai * HALF + wr * 64 + m * 16 + fr) * 1024 + col0;
#pragma unroll
                for (int bj = 0; bj < 2; ++bj) xw[ai][m][bj] = *(const u32x4*)(XB + off + bj * HALF); }
        f32x4 gv[2][2];
#pragma unroll
        for (int bj = 0; bj < 2; ++bj)
#pragma unroll
            for (int n = 0; n < 2; ++n) gv[bj][n] = *(const f32x4*)(g1 + col0 + bj * HALF + n * 4);
#pragma unroll
        for (int ai = 0; ai < 2; ++ai)
#pragma unroll
            for (int m = 0; m < 4; ++m) {
                float s = 0.f;
#pragma unroll
                for (int bj = 0; bj < 2; ++bj)
#pragma unroll
                    for (int n = 0; n < 2; ++n) { const f32x4 x = acc[ai][bj][m][n]; s += (x[0] * x[0] + x[1] * x[1]) + (x[2] * x[2] + x[3] * x[3]); }
                s += __shfl_xor(s, 16); s += __shfl_xor(s, 32);
                if (fq == 0) P[(ai * HALF + wr * 64 + m * 16 + fr) * 4 + wc] = s;
            }
        asm volatile("s_waitcnt lgkmcnt(0)" ::: "memory"); __builtin_amdgcn_s_barrier(); asm volatile("" ::: "memory");
        const int row = wid * 32 + (lane & 31);
        if (lane < 32) {
            const f32x4 p4 = *(const PG8_LAS f32x4*)(P + row * 4);
            const float t = (p4[0] + p4[1]) + (p4[2] + p4[3]);
            __hip_atomic_store((gu32_t*)(xbuf + ((size_t)(pmg * BM + row) * 4 + u.pn)), __builtin_bit_cast(unsigned, t), __ATOMIC_RELAXED, __HIP_MEMORY_SCOPE_AGENT);
        }
        asm volatile("s_waitcnt vmcnt(0)" ::: "memory");
        if (lane == 0) __hip_atomic_fetch_add((gu32_t*)(cnt + 64 * pmg), 1u, __ATOMIC_RELAXED, __HIP_MEMORY_SCOPE_AGENT);
        if (wid == 0) {
            unsigned spins = 0;
            while ((unsigned)__builtin_amdgcn_readfirstlane(__hip_atomic_load((gu32_t*)(cnt + 64 * pmg), __ATOMIC_RELAXED, __HIP_MEMORY_SCOPE_AGENT)) < 32u) { __builtin_amdgcn_s_sleep(2); if (++spins > (1u << 22)) break; }
        }
        asm volatile("s_waitcnt vmcnt(0) lgkmcnt(0)" ::: "memory"); __builtin_amdgcn_s_barrier(); asm volatile("" ::: "memory");
        if (lane < 32) {
            const gu32_t* slot = (const gu32_t*)(xbuf + (size_t)(pmg * BM + row) * 4);
            float tot = 0.f;
#pragma unroll
            for (int t = 0; t < 4; ++t) tot += __builtin_bit_cast(float, __hip_atomic_load(slot + t, __ATOMIC_RELAXED, __HIP_MEMORY_SCOPE_AGENT));
            S[row] = __builtin_amdgcn_rsqf(tot * (1.0f / 1024.0f) + 1e-6f);
        }
        asm volatile("s_waitcnt lgkmcnt(0)" ::: "memory"); __builtin_amdgcn_s_barrier(); asm volatile("" ::: "memory");
#pragma unroll
        for (int ai = 0; ai < 2; ++ai)
#pragma unroll
            for (int m = 0; m < 4; ++m) {
                const int r = ai * HALF + wr * 64 + m * 16 + fr; const float r1 = S[r]; const size_t off = (size_t)(pmg * BM + r) * 1024 + col0;
                float s2 = 0.f;
#pragma unroll
                for (int bj = 0; bj < 2; ++bj) {
                    const u32x4 w = xw[ai][m][bj];
                    f32x4 x0 = {__uint_as_float(w.x << 16), __uint_as_float(w.x & 0xffff0000u), __uint_as_float(w.y << 16), __uint_as_float(w.y & 0xffff0000u)};
                    f32x4 x1 = {__uint_as_float(w.z << 16), __uint_as_float(w.z & 0xffff0000u), __uint_as_float(w.w << 16), __uint_as_float(w.w & 0xffff0000u)};
                    x0 = x0 + acc[ai][bj][m][0] * r1 * gv[bj][0]; x1 = x1 + acc[ai][bj][m][1] * r1 * gv[bj][1];
                    s2 += ((x0[0] * x0[0] + x0[1] * x0[1]) + (x0[2] * x0[2] + x0[3] * x0[3])) + ((x1[0] * x1[0] + x1[1] * x1[1]) + (x1[2] * x1[2] + x1[3] * x1[3]));
                    if (outf) { *(f32x4*)(outf + off + bj * HALF) = x0; *(f32x4*)(outf + off + bj * HALF + 4) = x1; }
                    else { u32x4 o; o.x = cvt_pk_bf16(x0[0], x0[1]); o.y = cvt_pk_bf16(x0[2], x0[3]); o.z = cvt_pk_bf16(x1[0], x1[1]); o.w = cvt_pk_bf16(x1[2], x1[3]); *(u32x4*)(XB + off + bj * HALF) = o; }
                }
                s2 += __shfl_xor(s2, 16); s2 += __shfl_xor(s2, 32);
                if (fq == 0) P[r * 4 + wc] = s2;
            }
        asm volatile("s_waitcnt lgkmcnt(0)" ::: "memory"); __builtin_amdgcn_s_barrier(); asm volatile("" ::: "memory");
        if (!outf && lane < 32) { const f32x4 p4 = *(const PG8_LAS f32x4*)(P + row * 4); SS2[(size_t)(pmg * BM + row) * 4 + u.pn] = (p4[0] + p4[1]) + (p4[2] + p4[3]); }
        asm volatile("s_waitcnt lgkmcnt(0)" ::: "memory"); __builtin_amdgcn_s_barrier(); asm volatile("" ::: "memory");
    }
};

template <class Epi, class Sched, bool ALIGN_EPI = false, bool SP2 = false>
__device__ __forceinline__ void gemm_phase(PG8_LAS unsigned char* lds, const Gemm g, const Sched& S, const Epi& E, const int tid_in) {
    const int tid = tid_in, wid = __builtin_amdgcn_readfirstlane(tid >> 6), lane = tid & 63, wr = wid >> 2, wc = wid & 3, fr = lane & 15, fq = lane >> 4;
    const int K = g.K, nt = K / BK;
    unsigned voffA[2], voffB[2];
#pragma unroll
    for (int i = 0; i < 2; ++i) { int R, C; stage_rc(tid * 16 + i * 8192, R, C); const int Rb = Epi::PERM ? ((R & ~31) + perm32(R & 31)) : R;
        voffA[i] = (unsigned)(R * K + C) * 2u; voffB[i] = (unsigned)(Rb * K + C) * 2u; }
    const size_t kstep = (size_t)(BK * 2);
    const size_t hstep = (size_t)HALF * K * 2;
    const size_t tstep = 2 * hstep;
    const unsigned ldsw = (unsigned)wid * 1024u;
    const int aoff = lds_byte(wr * 64 + fr, fq * 8), boff = lds_byte(wc * 32 + fr, fq * 8);
#define PG8_SA(b, h) (((b) * 2 + (h)) * HTB)
#define PG8_SB(b, h) ((4 + (b) * 2 + (h)) * HTB)
#define PG8_STAGE(bufoff, gbase, voff) do { _Pragma("unroll") for (int _i = 0; _i < 2; ++_i) \
        __builtin_amdgcn_global_load_lds((const unsigned*)((const char*)(gbase) + (voff)[_i]), (PG8_LAS unsigned*)(lds + (bufoff) + ldsw + _i * 8192), 16, 0, 0); } while (0)
#define PG8_LDA(dst, b, h) do { _Pragma("unroll") for (int m = 0; m < 4; ++m) _Pragma("unroll") for (int k = 0; k < 2; ++k) dst[m][k] = *(const PG8_LAS bf16x8*)(lds + PG8_SA(b, h) + aoff + m * 2048 + k * 1024); } while (0)
#define PG8_LDB(dst, b, h) do { _Pragma("unroll") for (int n = 0; n < 2; ++n) _Pragma("unroll") for (int k = 0; k < 2; ++k) dst[n][k] = *(const PG8_LAS bf16x8*)(lds + PG8_SB(b, h) + boff + n * 2048 + k * 1024); } while (0)
#define PG8_MMA(ai, bj, At, Bt) do { __builtin_amdgcn_s_setprio(1); _Pragma("unroll") for (int m = 0; m < 4; ++m) _Pragma("unroll") for (int n = 0; n < 2; ++n) _Pragma("unroll") for (int k = 0; k < 2; ++k) \
        acc[ai][bj][m][n] = __builtin_amdgcn_mfma_f32_16x16x32_bf16(Bt[n][k], At[m][k], acc[ai][bj][m][n], 0, 0, 0); __builtin_amdgcn_s_setprio(0); } while (0)
#define PG8_WAIT_V(n) asm volatile("s_waitcnt vmcnt(" #n ")" ::: "memory")
#define PG8_WAIT_L(n) asm volatile("s_waitcnt lgkmcnt(" #n ")" ::: "memory")
#define PG8_BAR __builtin_amdgcn_s_barrier()
#define PG8_SCHED __builtin_amdgcn_sched_barrier(0)
    Unit cur, nxt; int ui = 0;
    if (!S.next(0, cur)) return;
    f32x4 acc[2][2][4][2];
#pragma unroll
    for (int a = 0; a < 2; ++a)
#pragma unroll
        for (int b = 0; b < 2; ++b)
#pragma unroll
            for (int m = 0; m < 4; ++m)
#pragma unroll
                for (int n = 0; n < 2; ++n) acc[a][b][m][n] = (f32x4){0.f, 0.f, 0.f, 0.f};
    bf16x8 At[4][2], B0[2][2], B1[2][2];
    const char* cA = (const char*)g.A + (size_t)cur.pm * tstep; const char* cB = (const char*)g.Bt + (size_t)cur.pn * tstep;
    S.a_ready(cur);
    if constexpr (SP2) {
        PG8_STAGE(PG8_SB(0, 0), cB, voffB); PG8_STAGE(PG8_SB(0, 1), cB + hstep, voffB); PG8_STAGE(PG8_SA(0, 0), cA, voffA); PG8_STAGE(PG8_SA(0, 1), cA + hstep, voffA);
        if (wr == 1) PG8_BAR;
        PG8_WAIT_V(2); PG8_BAR;
        PG8_STAGE(PG8_SB(1, 0), cB + kstep, voffB); PG8_STAGE(PG8_SA(1, 0), cA + kstep, voffA); PG8_STAGE(PG8_SB(1, 1), cB + hstep + kstep, voffB);
        PG8_WAIT_V(6); PG8_BAR;
    } else {
        PG8_STAGE(PG8_SB(0, 0), cB, voffB); PG8_STAGE(PG8_SA(0, 0), cA, voffA); PG8_STAGE(PG8_SB(0, 1), cB + hstep, voffB); PG8_STAGE(PG8_SA(0, 1), cA + hstep, voffA);
        if (wr == 1) PG8_BAR;
        PG8_WAIT_V(4); PG8_BAR;
        PG8_STAGE(PG8_SB(1, 0), cB + kstep, voffB); PG8_STAGE(PG8_SA(1, 0), cA + kstep, voffA); PG8_STAGE(PG8_SB(1, 1), cB + hstep + kstep, voffB);
        PG8_WAIT_V(6); PG8_BAR;
    }
    for (;;) {
        const bool has_next = S.next(ui + 1, nxt);
        const char* nA = has_next ? (const char*)g.A + (size_t)nxt.pm * tstep : cA; const char* nB = has_next ? (const char*)g.Bt + (size_t)nxt.pn * tstep : cB;
        for (int t = 0; t < nt; t += 2) {
            const bool last = (t == nt - 2);
            const char* a1 = cA + (size_t)(t + 1) * kstep;
            const char* a2 = last ? nA : cA + (size_t)(t + 2) * kstep; const char* b2 = last ? nB : cB + (size_t)(t + 2) * kstep;
            const char* a3 = a2 + kstep; const char* b3 = b2 + kstep;
            if (last && has_next) S.a_ready(nxt);
            if constexpr (SP2) {
            PG8_LDB(B0, 0, 0); PG8_LDB(B1, 0, 1); PG8_SCHED; PG8_LDA(At, 0, 0); PG8_STAGE(PG8_SA(1, 1), a1 + hstep, voffA);
            PG8_WAIT_V(8); PG8_WAIT_L(0); PG8_BAR; PG8_MMA(0, 0, At, B0); PG8_MMA(0, 1, At, B1); PG8_BAR; PG8_SCHED;
            PG8_LDA(At, 0, 1); PG8_STAGE(PG8_SB(0, 0), b2, voffB); PG8_STAGE(PG8_SB(0, 1), b2 + hstep, voffB); PG8_STAGE(PG8_SA(0, 0), a2, voffA);
            PG8_WAIT_V(8); PG8_WAIT_L(0); PG8_BAR; PG8_MMA(1, 0, At, B0); PG8_MMA(1, 1, At, B1); PG8_BAR; PG8_SCHED;
            PG8_LDB(B0, 1, 0); PG8_LDB(B1, 1, 1); PG8_SCHED; PG8_LDA(At, 1, 0); PG8_STAGE(PG8_SA(0, 1), a2 + hstep, voffA);
            PG8_WAIT_V(8); PG8_WAIT_L(0); PG8_BAR; PG8_MMA(0, 0, At, B0); PG8_MMA(0, 1, At, B1); PG8_BAR; PG8_SCHED;
            PG8_LDA(At, 1, 1); PG8_STAGE(PG8_SB(1, 0), b3, voffB); PG8_STAGE(PG8_SB(1, 1), b3 + hstep, voffB); PG8_STAGE(PG8_SA(1, 0), a3, voffA);
            PG8_WAIT_V(8); PG8_WAIT_L(0); PG8_BAR; PG8_MMA(1, 0, At, B0); PG8_MMA(1, 1, At, B1); PG8_BAR; PG8_SCHED;
            } else {
            PG8_LDB(B0, 0, 0); PG8_SCHED; PG8_LDA(At, 0, 0); PG8_STAGE(PG8_SA(1, 1), a1 + hstep, voffA);
            PG8_WAIT_L(8); PG8_BAR; PG8_WAIT_L(0); PG8_MMA(0, 0, At, B0); PG8_BAR; PG8_SCHED;
            PG8_LDB(B1, 0, 1); PG8_STAGE(PG8_SB(0, 0), b2, voffB);
            PG8_BAR; PG8_WAIT_L(0); PG8_MMA(0, 1, At, B1); PG8_BAR;
            PG8_LDA(At, 0, 1); PG8_STAGE(PG8_SA(0, 0), a2, voffA);
            PG8_BAR; PG8_WAIT_L(0); PG8_MMA(1, 0, At, B0); PG8_BAR; PG8_SCHED;
            PG8_STAGE(PG8_SB(0, 1), b2 + hstep, voffB);
            PG8_WAIT_V(6); PG8_BAR; PG8_MMA(1, 1, At, B1); PG8_BAR;
            PG8_LDB(B0, 1, 0); PG8_SCHED; PG8_LDA(At, 1, 0); PG8_STAGE(PG8_SA(0, 1), a2 + hstep, voffA);
            PG8_WAIT_L(8); PG8_BAR; PG8_WAIT_L(0); PG8_MMA(0, 0, At, B0); PG8_BAR; PG8_SCHED;
            PG8_LDB(B1, 1, 1); PG8_STAGE(PG8_SB(1, 0), b3, voffB);
            PG8_BAR; PG8_WAIT_L(0); PG8_MMA(0, 1, At, B1); PG8_BAR;
            PG8_LDA(At, 1, 1); PG8_STAGE(PG8_SA(1, 0), a3, voffA);
            PG8_BAR; PG8_WAIT_L(0); PG8_MMA(1, 0, At, B0); PG8_BAR; PG8_SCHED;
            PG8_STAGE(PG8_SB(1, 1), b3 + hstep, voffB);
            PG8_WAIT_V(6); PG8_BAR; PG8_MMA(1, 1, At, B1); PG8_BAR;
            }
        }
        if constexpr (ALIGN_EPI) { if (wr == 0) PG8_BAR; }
        if constexpr (!Epi::AFTER_DRAIN) { E(acc, cur, wr, wc, fr, fq); S.done(cur); }
        if (!has_next) break;
#pragma unroll
        for (int a = 0; a < 2; ++a)
#pragma unroll
            for (int b = 0; b < 2; ++b)
#pragma unroll
                for (int m = 0; m < 4; ++m)
#pragma unroll
                    for (int n = 0; n < 2; ++n) acc[a][b][m][n] = (f32x4){0.f, 0.f, 0.f, 0.f};
        cur = nxt; cA = nA; cB = nB; ++ui;
        if constexpr (ALIGN_EPI) { if (wr == 1) PG8_BAR; }
    }
    PG8_WAIT_V(0);
    if constexpr (!ALIGN_EPI) { if (wr == 0) PG8_BAR; }
    PG8_BAR;
    if constexpr (Epi::AFTER_DRAIN) { E.fused(acc, cur, wr, wc, fr, fq, lds, wid, lane); S.done(cur); }
#undef PG8_SA
#undef PG8_SB
#undef PG8_STAGE
#undef PG8_LDA
#undef PG8_LDB
#undef PG8_MMA
#undef PG8_WAIT_V
#undef PG8_WAIT_L
#undef PG8_BAR
#undef PG8_SCHED
}
}

#ifndef REP_MIXC
#define REP_MIXC 1
#endif
#ifndef REP_MIXA
#define REP_MIXA 1
#endif
#ifndef REP_MIXB
#define REP_MIXB 1
#endif
#ifndef WGM_FF1
#define WGM_FF1 4
#endif
#ifndef WGM_IN
#define WGM_IN 4
#endif
#ifndef WGM_FZ
#define WGM_FZ 8
#endif
#ifndef WGM_Q
#define WGM_Q 8
#endif
#ifndef REP_GEMM
#define REP_GEMM 1
#endif
#ifndef REP_ATTN
#define REP_ATTN 1
#endif
#ifndef REP_MIX
#define REP_MIX 1
#endif
#ifndef REP_P0
#define REP_P0 1
#endif
#ifndef REP_SYNC
#define REP_SYNC 1
#endif
#ifndef MK_N_LAUNCHES
#define MK_N_LAUNCHES 1
#endif
constexpr int BATCH = 2, SEQ = 16384, D = 1024, M = BATCH * SEQ, DEPTH = 2;
constexpr int NMEM = 256, MMEM = BATCH * NMEM;
constexpr int W_A = 256, W_B = 384, W_C = 384, D_IN = 1792, FF = 4096, CONV_K = 31;
constexpr int ZB_OFF = W_A, ZV_OFF = W_A + W_B, ZC_OFF = W_A + 2 * W_B, ZG_OFF = ZC_OFF + W_C;
constexpr float EPS = 1e-6f;
constexpr int NWAVES = 8, NTHREADS = 512;
constexpr int LDS_BYTES = 147456, MISC_OFF = 143360;
constexpr size_t WS_CTL = 0, CTL_ZERO_BYTES = 524288; constexpr int CW_BAR = 1024, CW_SEAM = 16384, SEAM_BANK = 128 * 64;
constexpr int NPH = 1 + 7 * DEPTH;

constexpr size_t MiB = 1u << 20;
constexpr size_t WS_W = 2 * MiB, WS_WL = 30 * MiB;
constexpr size_t WO_IN = 0, WO_OUT = 4 * MiB, WO_Q = 6 * MiB, WO_K = 8 * MiB, WO_V = 10 * MiB, WO_O = 12 * MiB, WO_1 = 14 * MiB, WO_2 = 22 * MiB;
constexpr size_t WS_SGW = 62 * MiB;
constexpr size_t WS_RS = 69 * MiB;
constexpr size_t WS_MN = 63 * MiB, WS_KB = 65 * MiB, WS_VT = 67 * MiB;
constexpr size_t WS_XN = 70 * MiB, WS_Y = 134 * MiB, WS_Z = 198 * MiB, WS_BUFA = 310 * MiB, WS_F = 198 * MiB, WS_XBUF = 454 * MiB  , WS_END = 458 * MiB;

typedef unsigned short bf16;
typedef short bf16x8 __attribute__((ext_vector_type(8)));
typedef float f32x4 __attribute__((ext_vector_type(4)));
typedef float f32x16 __attribute__((ext_vector_type(16)));
typedef unsigned u32x4 __attribute__((ext_vector_type(4)));
typedef unsigned u32x2 __attribute__((ext_vector_type(2)));
#define LAS __attribute__((address_space(3)))
#define LDS_WAIT() asm volatile("s_waitcnt lgkmcnt(0)" ::: "memory")

__device__ __forceinline__ float bf2f(unsigned v) { return __uint_as_float(v << 16); }
__device__ __forceinline__ float bflo(unsigned w) { return __uint_as_float(w << 16); }
__device__ __forceinline__ float bfhi(unsigned w) { return __uint_as_float(w & 0xffff0000u); }
__device__ __forceinline__ unsigned pk2(float lo, float hi) { return pg8::cvt_pk_bf16(lo, hi); }
__device__ __forceinline__ float wave_sum(float v) {
#pragma unroll
    for (int o = 1; o < 64; o <<= 1) v += __shfl_xor(v, o);
    return v;
}
__device__ __forceinline__ float fast_rcp(float x) { return __builtin_amdgcn_rcpf(x); }
__device__ __forceinline__ float fast_rsq(float x) { return __builtin_amdgcn_rsqf(x); }
__device__ __forceinline__ float sigmoidf_(float x) { return fast_rcp(1.0f + __builtin_amdgcn_exp2f(-1.4426950409f * x)); }
__device__ __forceinline__ float gelu_tanh(float x) { const float u = x + 0.044715f * x * x * x; return x * fast_rcp(1.0f + __builtin_amdgcn_exp2f(-2.302208198f * u)); }

#define XB_TMO      128
#define XB_XCNT(j)  (256  + 64 * (j))
#define XB_XSUB(j)  (1280 + 64 * (j))
#define XB_XGEN(j)  (2304 + 64 * (j))
#define XB_TOP      3328
#define XB_TOPGEN   3392
#define XCD_BAR_WORDS 3456
#define XB_SPIN_CAP (1u << 18)

__device__ __forceinline__ unsigned xb_ld(unsigned* p)              { return __hip_atomic_load(p, __ATOMIC_RELAXED, __HIP_MEMORY_SCOPE_AGENT); }
__device__ __forceinline__ unsigned xb_add(unsigned* p, unsigned v) { return __hip_atomic_fetch_add(p, v, __ATOMIC_RELAXED, __HIP_MEMORY_SCOPE_AGENT); }
__device__ __forceinline__ unsigned xb_xcc_id() { return (unsigned)__builtin_amdgcn_s_getreg((3 << 11) | 20) & 0xFu; }
#define XB_SPIN(cond, bar) do { unsigned _sp = 0; while (cond) { __builtin_amdgcn_s_sleep(1); \
    if ((++_sp & 255u) == 0u) { if (xb_ld(&(bar)[XB_TMO])) break; if (_sp > XB_SPIN_CAP) { atomicAdd(&(bar)[XB_TMO], 1u); break; } } } } while (0)

struct XcdBarrier {
    unsigned* bar; unsigned x;
    volatile LAS unsigned* st;
};

__device__ __forceinline__ XcdBarrier xcd_barrier_post(unsigned* bar, volatile LAS unsigned* st, const bool leader) {
    XcdBarrier b; b.bar = bar; b.x = xb_xcc_id(); b.st = st;
    if (leader) (void)xb_add(&bar[XB_XCNT(b.x)], 1u);
    return b;
}
__device__ __forceinline__ void xcd_barrier_complete(unsigned* bar, unsigned x, unsigned& nloc, unsigned& nx) {
    const unsigned G = gridDim.x * gridDim.y * gridDim.z;
    unsigned sum, cnt, mine, sp = 0u;
    for (;;) {
        sum = 0u; cnt = 0u; mine = 0u;
#pragma unroll
        for (unsigned j = 0; j < 16; ++j) { const unsigned c = xb_ld(&bar[XB_XCNT(j)]); sum += c; cnt += (c > 0u) ? 1u : 0u; mine = (j == x) ? c : mine; }
        if (sum == G) break;
        __builtin_amdgcn_s_sleep(1);
        if ((++sp & 255u) == 0u) { if (xb_ld(&bar[XB_TMO])) break; if (sp > XB_SPIN_CAP) { atomicAdd(&bar[XB_TMO], 1u); break; } }
    }
    nloc = mine > 0u ? mine : 1u; nx = cnt > 0u ? cnt : 1u;
}

__device__ __forceinline__ void xcd_barrier(const XcdBarrier& b, const bool leader) {
    asm volatile("s_waitcnt vmcnt(0)" ::: "memory");
    __syncthreads();
    if (leader) {
        unsigned* bar = b.bar;
        __builtin_amdgcn_s_waitcnt(0);
        unsigned nloc = b.st[0], nx = b.st[1];
        if (nloc == 0u) { xcd_barrier_complete(bar, b.x, nloc, nx); b.st[0] = nloc; b.st[1] = nx; }
        const unsigned old = xb_add(&bar[XB_XSUB(b.x)], 1u);
        const unsigned gen = old / nloc;
        if (old + 1u == (gen + 1u) * nloc) {
            __builtin_amdgcn_fence(__ATOMIC_RELEASE, "agent");
            asm volatile("s_waitcnt vmcnt(0)" ::: "memory");
            const unsigned og = xb_add(&bar[XB_TOP], 1u);
            const unsigned tg = og / nx;
            asm volatile("buffer_inv sc1" ::: "memory");
            if (og + 1u == (tg + 1u) * nx) xb_add(&bar[XB_TOPGEN], 1u);
            else XB_SPIN(xb_ld(&bar[XB_TOPGEN]) == tg, bar);
            xb_add(&bar[XB_XGEN(b.x)], 1u);
            asm volatile("s_waitcnt vmcnt(0)" ::: "memory");
        } else {
            asm volatile("buffer_inv sc1" ::: "memory");
            XB_SPIN(xb_ld(&bar[XB_XGEN(b.x)]) == gen, bar);
            asm volatile("s_waitcnt vmcnt(0)" ::: "memory");
        }
    }
    __syncthreads();
}

__device__ __forceinline__ int mk_tid(int wave0) { unsigned m = ~0u; asm volatile("" : "+s"(m)); const int l = __builtin_amdgcn_mbcnt_hi(m, __builtin_amdgcn_mbcnt_lo(m, 0u)); return wave0 * 64 + l; }

struct Args { const float* in[28]; float* out; unsigned char* ws; int ph_lo, ph_hi; };
#define AS4 __attribute__((address_space(4)))
typedef const float* cfptr; typedef float* fptr;
#define KIN(i) (*(const AS4 cfptr*)(kargs + kz + 8 * (i)))
#define KOUT (*(const AS4 fptr*)(kargs + kz + 224))

__device__ __forceinline__ void p0_transpose_item(const float* W, int K, int N, bf16* WT, LAS float* scr, int item, int lane, const float* gk) {
    const int nblk = N / 32, kb = item / nblk, nb = item % nblk, k0 = 64 * kb, n0 = 32 * nb;
#pragma unroll
    for (int i = 0; i < 8; ++i) { const int kk = 8 * i + (lane >> 3), c4 = (lane & 7) * 4; f32x4 v = *(const f32x4*)(W + (size_t)(k0 + kk) * N + n0 + c4);
        if (gk) v = v * gk[k0 + kk];
        scr[kk * 33 + c4] = v.x; scr[kk * 33 + c4 + 1] = v.y; scr[kk * 33 + c4 + 2] = v.z; scr[kk * 33 + c4 + 3] = v.w; }
    LDS_WAIT(); asm volatile("" ::: "memory");
    const int c = lane & 7;
#pragma unroll
    for (int j = 0; j < 4; ++j) { const int n = (lane >> 3) + 8 * j; const LAS float* s = scr + (8 * c) * 33 + n;
        u32x4 o; o.x = pk2(s[0 * 33], s[1 * 33]); o.y = pk2(s[2 * 33], s[3 * 33]); o.z = pk2(s[4 * 33], s[5 * 33]); o.w = pk2(s[6 * 33], s[7 * 33]);
        *(u32x4*)(WT + (size_t)(n0 + n) * K + k0 + 8 * c) = o; }
    LDS_WAIT(); asm volatile("" ::: "memory");
}
__device__ __forceinline__ void x_row_to_bf16(const float* xrow, bf16* orow, float* rs, int lane) {
    const f32x4* xr = (const f32x4*)xrow + lane;
    f32x4 v[4]; float s = 0.f;
#pragma unroll
    for (int j = 0; j < 4; ++j) { v[j] = xr[64 * j]; s += (v[j].x * v[j].x + v[j].y * v[j].y) + (v[j].z * v[j].z + v[j].w * v[j].w); }
    const float r = fast_rsq(wave_sum(s) * (1.f / D) + EPS);
    if (lane == 0) *rs = r;
    u32x2* o8 = (u32x2*)orow + lane;
#pragma unroll
    for (int j = 0; j < 4; ++j) { u32x2 w; w.x = pk2(v[j].x, v[j].y); w.y = pk2(v[j].z, v[j].w); o8[64 * j] = w; }
}
__device__ __forceinline__ void rms_row_to_bf16(const float* xrow, const float* g, bf16* orow, int lane) {
    const f32x4* xr = (const f32x4*)xrow + lane; const f32x4* gr = (const f32x4*)g + lane;
    f32x4 v[4]; float s = 0.f;
#pragma unroll
    for (int j = 0; j < 4; ++j) { v[j] = xr[64 * j]; s += (v[j].x * v[j].x + v[j].y * v[j].y) + (v[j].z * v[j].z + v[j].w * v[j].w); }
    const float r = 1.0f / sqrtf(wave_sum(s) * (1.f / D) + EPS);
    u32x2* o8 = (u32x2*)orow + lane;
#pragma unroll
    for (int j = 0; j < 4; ++j) { const f32x4 gg = gr[64 * j]; u32x2 w; w.x = pk2(v[j].x * r * gg.x, v[j].y * r * gg.y); w.y = pk2(v[j].z * r * gg.z, v[j].w * r * gg.w); o8[64 * j] = w; }
}

__device__ __forceinline__ void p0_prologue(const AS4 unsigned char* kargs, int kz, unsigned char* ws_, LAS unsigned char* lds, int gw, int NGW, int wave, int lane) {
    LAS float* scr = (LAS float*)(lds + wave * 16384);
    constexpr int I_IN = (D / 64) * (D_IN / 32), I_SQ = (D / 64) * (D / 32), I_1 = (D / 64) * (FF / 32), I_2 = (FF / 64) * (D / 32);
    constexpr int I_L = I_IN + 5 * I_SQ + I_1 + I_2;
    for (int it = gw; it < DEPTH * I_L; it += NGW) {
        const int l = it / I_L; int r = it % I_L;
        unsigned char* wb = ws_ + WS_W + (size_t)l * WS_WL;
        if (r < I_IN) { p0_transpose_item(KIN(3) + (size_t)l * D * D_IN, D, D_IN, (bf16*)(wb + WO_IN), scr, r, lane, KIN(2) + (size_t)l * D); continue; } r -= I_IN;
        if (r < I_SQ) { p0_transpose_item(KIN(15) + (size_t)l * D * D, D, D, (bf16*)(wb + WO_OUT), scr, r, lane, nullptr); continue; } r -= I_SQ;
        if (r < I_SQ) { p0_transpose_item(KIN(19) + (size_t)l * D * D, D, D, (bf16*)(wb + WO_Q), scr, r, lane, KIN(17) + (size_t)l * D); continue; } r -= I_SQ;
        if (r < I_SQ) { p0_transpose_item(KIN(20) + (size_t)l * D * D, D, D, (bf16*)(wb + WO_K), scr, r, lane, nullptr); continue; } r -= I_SQ;
        if (r < I_SQ) { p0_transpose_item(KIN(21) + (size_t)l * D * D, D, D, (bf16*)(wb + WO_V), scr, r, lane, nullptr); continue; } r -= I_SQ;
        if (r < I_SQ) { p0_transpose_item(KIN(22) + (size_t)l * D * D, D, D, (bf16*)(wb + WO_O), scr, r, lane, nullptr); continue; } r -= I_SQ;
        if (r < I_1) { p0_transpose_item(KIN(25) + (size_t)l * D * FF, D, FF, (bf16*)(wb + WO_1), scr, r, lane, KIN(24) + (size_t)l * D); continue; } r -= I_1;
        p0_transpose_item(KIN(26) + (size_t)l * FF * D, FF, D, (bf16*)(wb + WO_2), scr, r, lane, nullptr);
    }
    for (int m0 = gw; m0 < M; m0 += 4 * NGW) {
        f32x4 v[4][4];
#pragma unroll
        for (int q = 0; q < 4; ++q) { const int m = m0 + q * NGW; if (m < M) { const f32x4* xr = (const f32x4*)(KIN(0) + (size_t)m * D) + lane;
#pragma unroll
            for (int j = 0; j < 4; ++j) v[q][j] = xr[64 * j]; } }
#pragma unroll
        for (int q = 0; q < 4; ++q) { const int m = m0 + q * NGW; if (m < M) {
            float s = 0.f;
#pragma unroll
            for (int j = 0; j < 4; ++j) s += (v[q][j].x * v[q][j].x + v[q][j].y * v[q][j].y) + (v[q][j].z * v[q][j].z + v[q][j].w * v[q][j].w);
            const float wave_sum_s = wave_sum(s);
            if (lane == 0) *(f32x4*)((float*)(ws_ + WS_RS) + 4 * (size_t)m) = (f32x4){wave_sum_s, 0.f, 0.f, 0.f};
            u32x2* o8 = (u32x2*)((bf16*)(ws_ + WS_XN) + (size_t)m * D) + lane;
#pragma unroll
            for (int j = 0; j < 4; ++j) { u32x2 w; w.x = pk2(v[q][j].x, v[q][j].y); w.y = pk2(v[q][j].z, v[q][j].w); o8[64 * j] = w; } } }
    }
    for (int mm = gw; mm < DEPTH * MMEM; mm += NGW) { const int l = mm / MMEM, r = mm % MMEM;
        rms_row_to_bf16(KIN(1) + (size_t)r * D, KIN(18) + (size_t)l * D, (bf16*)(ws_ + WS_MN + (size_t)l * MiB) + (size_t)r * D, lane); }
    { const int gt = gw * 64 + lane, NGT = NGW * 64;
      for (int i = gt; i < DEPTH * 4 * 128 * 128 / 8; i += NGT) {
          const int e0 = i * 8, s0 = e0 & 127, t = (e0 >> 7) & 127;
          const f32x4 a0 = *(const f32x4*)(KIN(9) + e0), a1 = *(const f32x4*)(KIN(9) + e0 + 4);
          float v[8] = {a0.x, a0.y, a0.z, a0.w, a1.x, a1.y, a1.z, a1.w};
#pragma unroll
          for (int e = 0; e < 8; ++e) v[e] = (s0 + e <= t) ? v[e] : 0.f;
          u32x4 o; o.x = pk2(v[0], v[1]); o.y = pk2(v[2], v[3]); o.z = pk2(v[4], v[5]); o.w = pk2(v[6], v[7]);
          *(u32x4*)((bf16*)(ws_ + WS_SGW) + e0) = o; } }
}

__device__ __forceinline__ void resnorm_phase(bf16* XB, const bf16* Y, const float* g1, float* RS, float* outf, int gw, int NGW, int lane) {
    f32x4 gg[4];
#pragma unroll
    for (int j = 0; j < 4; ++j) gg[j] = ((const f32x4*)g1)[lane + 64 * j];
    for (int m0 = gw; m0 < M; m0 += 2 * NGW) {
        u32x2 yw[2][4], xw[2][4];
#pragma unroll
        for (int q = 0; q < 2; ++q) { const int m = m0 + q * NGW; if (m < M) {
            const u32x2* yr = (const u32x2*)(Y + (size_t)m * D) + lane; const u32x2* xr = (const u32x2*)(XB + (size_t)m * D) + lane;
#pragma unroll
            for (int j = 0; j < 4; ++j) { yw[q][j] = yr[64 * j]; xw[q][j] = xr[64 * j]; } } }
#pragma unroll
        for (int q = 0; q < 2; ++q) { const int m = m0 + q * NGW; if (m < M) {
            f32x4 yv[4]; float ss = 0.f;
#pragma unroll
            for (int j = 0; j < 4; ++j) { const u32x2 w = yw[q][j]; yv[j] = (f32x4){bflo(w.x), bfhi(w.x), bflo(w.y), bfhi(w.y)};
                ss += (yv[j].x * yv[j].x + yv[j].y * yv[j].y) + (yv[j].z * yv[j].z + yv[j].w * yv[j].w); }
            const float r1 = fast_rsq(wave_sum(ss) * (1.f / D) + EPS);
            float s2 = 0.f; f32x4 xv[4];
#pragma unroll
            for (int j = 0; j < 4; ++j) { const u32x2 w = xw[q][j]; xv[j] = (f32x4){bflo(w.x), bfhi(w.x), bflo(w.y), bfhi(w.y)} + yv[j] * r1 * gg[j];
                s2 += (xv[j].x * xv[j].x + xv[j].y * xv[j].y) + (xv[j].z * xv[j].z + xv[j].w * xv[j].w); }
            if (outf) { f32x4* xo = (f32x4*)(outf + (size_t)m * D) + lane;
#pragma unroll
                for (int j = 0; j < 4; ++j) xo[64 * j] = xv[j];
            } else {
                const float r2 = fast_rsq(wave_sum(s2) * (1.f / D) + EPS);
                if (lane == 0) RS[m] = r2;
                u32x2* o8 = (u32x2*)(XB + (size_t)m * D) + lane;
#pragma unroll
                for (int j = 0; j < 4; ++j) { u32x2 w; w.x = pk2(xv[j].x, xv[j].y); w.y = pk2(xv[j].z, xv[j].w); o8[64 * j] = w; }
            } } }
    }
}

struct MixP { const bf16* Z; bf16* YC; const float *pool_w, *pool_scale, *sg_ln_g, *sg_ln_b, *sg_b, *conv_w, *conv_b, *conv_ln_g, *conv_ln_b; const bf16* SGW; };

constexpr int MX_H = 0, MX_AT = 0, MX_PWT = 0, MX_P = 73728, MX_VT = 0, MX_LNT = 106496;
constexpr int PWT_LD = 72, P_LD = 264, VT_LD = 136;

__device__ __forceinline__ void mixer_unit(LAS unsigned char* lds, const MixP& p, int unit, const int wave) {
    const int t0 = unit * 128, s0 = t0 % SEQ;
    const bf16* Zb = p.Z + (size_t)t0 * D_IN;
    bf16* Yb = p.YC + (size_t)t0 * D;
    typedef float f32x2 __attribute__((ext_vector_type(2)));
#ifndef SKIP_CONV
    for (int repc = 0; repc < REP_MIXC; ++repc) {
        const int tid = mk_tid(wave), lane = tid & 63;
        LAS bf16* H = (LAS bf16*)(lds + MX_H);
#pragma unroll 1
        for (int bb = 0; bb < 2; ++bb) {
            u32x4 av[8], gv[8];
#pragma unroll
            for (int j = 0; j < 8; ++j) {
                const int idx = (bb * 8 + j) * NTHREADS + tid, r = idx / 48, vv = idx - r * 48, srel = r - 30;
                av[j] = (u32x4){0u, 0u, 0u, 0u}; gv[j] = av[j];
                if (idx < 158 * 48 && s0 + srel >= 0) { const bf16* zr = Zb + (ptrdiff_t)srel * D_IN + ZC_OFF + 8 * vv; av[j] = *(const u32x4*)zr; gv[j] = *(const u32x4*)(zr + W_C); }
            }
#pragma unroll
            for (int j = 0; j < 8; ++j) {
                const int idx = (bb * 8 + j) * NTHREADS + tid, r = idx / 48, vv = idx - r * 48;
                u32x4 o;
                o.x = pk2(bflo(av[j].x) * sigmoidf_(bflo(gv[j].x)), bfhi(av[j].x) * sigmoidf_(bfhi(gv[j].x)));
                o.y = pk2(bflo(av[j].y) * sigmoidf_(bflo(gv[j].y)), bfhi(av[j].y) * sigmoidf_(bfhi(gv[j].y)));
                o.z = pk2(bflo(av[j].z) * sigmoidf_(bflo(gv[j].z)), bfhi(av[j].z) * sigmoidf_(bfhi(gv[j].z)));
                o.w = pk2(bflo(av[j].w) * sigmoidf_(bflo(gv[j].w)), bfhi(av[j].w) * sigmoidf_(bfhi(gv[j].w)));
                if (idx < 158 * 48) *(LAS u32x4*)(H + r * W_C + 8 * vv) = o;
            }
        }
        __syncthreads();
        {
            const int tok0 = wave * 16;
            f32x2 acc[3][16];
#pragma unroll
            for (int ch = 0; ch < 3; ++ch) {
                int ln = lane; asm volatile("" : "+v"(ln));
                const int c = ch * 128 + 2 * ln;
                f32x2 w[CONV_K];
#pragma unroll
                for (int k = 0; k < CONV_K; ++k) w[k] = *(const f32x2*)(p.conv_w + k * W_C + c);
                const f32x2 cb = *(const f32x2*)(p.conv_b + c);
#pragma unroll
                for (int j = 0; j < 16; ++j) acc[ch][j] = cb;
                const LAS bf16* hp = H + tok0 * W_C + c;
#pragma unroll
                for (int q = 0; q < 46; ++q) {
                    const unsigned hw = *(const LAS unsigned*)(hp + q * W_C);
                    const f32x2 h2 = {bflo(hw), bfhi(hw)};
#pragma unroll
                    for (int j = 0; j < 16; ++j) { if (q - j >= 0 && q - j < CONV_K) acc[ch][j] = acc[ch][j] + h2 * w[q - j]; }
                }
                asm volatile("" ::: "memory");
            }
            float v[32];
#pragma unroll
            for (int j = 0; j < 16; ++j) {
                float s1 = 0.f, s2 = 0.f;
#pragma unroll
                for (int ch = 0; ch < 3; ++ch) { s1 += acc[ch][j].x + acc[ch][j].y; s2 += acc[ch][j].x * acc[ch][j].x + acc[ch][j].y * acc[ch][j].y; }
                v[j] = s1; v[16 + j] = s2;
            }
#pragma unroll
            for (int step = 0; step < 5; ++step) {
                const int half = 16 >> step, mask = 32 >> step;
                const bool b = (lane & mask) != 0;
#pragma unroll
                for (int jj = 0; jj < half; ++jj) {
                    const float send = b ? v[jj] : v[half + jj], keep = b ? v[half + jj] : v[jj];
                    v[jj] = keep + __shfl_xor(send, mask);
                }
            }
            const float vt = v[0] + __shfl_xor(v[0], 1);
            int ln = lane; asm volatile("" : "+v"(ln));
            f32x2 lgv[3], lbv[3];
#pragma unroll
            for (int ch = 0; ch < 3; ++ch) { lgv[ch] = *(const f32x2*)(p.conv_ln_g + ch * 128 + 2 * ln); lbv[ch] = *(const f32x2*)(p.conv_ln_b + ch * 128 + 2 * ln); }
#pragma unroll
            for (int j = 0; j < 16; ++j) {
                const float S1 = __int_as_float(__builtin_amdgcn_readlane(__float_as_int(vt), 2 * j));
                const float S2 = __int_as_float(__builtin_amdgcn_readlane(__float_as_int(vt), 32 + 2 * j));
                const float mean = S1 * (1.f / W_C);
                const float var = S2 * (1.f / W_C) - mean * mean;
                const float rstd = fast_rsq(fmaxf(var, 0.f) + EPS);
                bf16* yr = Yb + (size_t)(tok0 + j) * D + W_A + W_B;
#pragma unroll
                for (int ch = 0; ch < 3; ++ch) {
                    const int c = ch * 128 + 2 * ln;
                    const f32x2 lg = lgv[ch], lb = lbv[ch];
                    const float y0 = (acc[ch][j].x - mean) * rstd * lg.x + lb.x, y1 = (acc[ch][j].y - mean) * rstd * lg.y + lb.y;
                    *(unsigned*)(yr + c) = pk2(y0 * sigmoidf_(y0), y1 * sigmoidf_(y1));
                }
            }
        }
        __syncthreads();
    }
#endif
#ifndef SKIP_POOL
    for (int repa = 0; repa < REP_MIXA; ++repa) {
        const int tid = mk_tid(wave), lane = tid & 63;
        LAS bf16* PWt = (LAS bf16*)(lds + MX_PWT);
        LAS bf16* P = (LAS bf16*)(lds + MX_P);
        LAS bf16* AT = (LAS bf16*)(lds + MX_AT);
        {
            u32x4 tt[9];
#pragma unroll
            for (int j = 0; j < 9; ++j) { const int idx = j * NTHREADS + tid, r = idx >> 5, c16 = idx & 31, srel = r - 15;
                tt[j] = (u32x4){0u, 0u, 0u, 0u};
                if (idx < 143 * 32 && s0 + srel >= 0) tt[j] = *(const u32x4*)(Zb + (ptrdiff_t)srel * D_IN + c16 * 8); }
#pragma unroll
            for (int j = 0; j < 9; ++j) { const int idx = j * NTHREADS + tid, r = idx >> 5, c16 = idx & 31;
                if (idx < 143 * 32) *(LAS u32x4*)(AT + r * 256 + c16 * 8) = tt[j]; }
        }
        float pw[32];
#pragma unroll
        for (int i = 0; i < 32; ++i) pw[i] = p.pool_w[i * NTHREADS + tid];
        __syncthreads();
        {
            const int ch = tid & 255, th = tid >> 8, g = ch >> 6, w = 2 << g, tstart = th * 64;
            const LAS bf16* ac = AT + 15 * 256 + ch;
            float win = 0.f;
            for (int jj = 1; jj < w; ++jj) win += bf2f(ac[(tstart - jj) * 256]);
#pragma unroll 1
            for (int t8 = tstart; t8 < tstart + 64; t8 += 8) {
                float an[8], ao[8];
#pragma unroll
                for (int e = 0; e < 8; ++e) { an[e] = bf2f(ac[(t8 + e) * 256]); ao[e] = bf2f(ac[(t8 + e - w + 1) * 256]); }
#pragma unroll
                for (int e = 0; e < 8; ++e) {
                    win += an[e];
                    const int cnt = min(s0 + t8 + e + 1, w);
                    const float pv = win * fast_rcp((float)cnt) - an[e];
                    P[(t8 + e) * P_LD + ch] = (bf16)(pk2(pv, 0.f) & 0xffffu);
                    win -= ao[e];
                }
            }
        }
        __syncthreads();
#pragma unroll
        for (int i = 0; i < 32; ++i) { const int idx = i * NTHREADS + tid, g = idx >> 12, c = (idx >> 6) & 63, d = idx & 63;
            const int slot = (d & 32) + 16 * ((d >> 2) & 1) + 4 * ((d >> 3) & 3) + (d & 3);
            PWt[(g * 64 + slot) * PWT_LD + c] = (bf16)(pk2(pw[i], 0.f) & 0xffffu); }
        __syncthreads();
        const int fr = lane & 15, fq = lane >> 4;
#pragma unroll
        for (int g = 0; g < 4; ++g) {
            bf16x8 pf[2];
#pragma unroll
            for (int ks = 0; ks < 2; ++ks) pf[ks] = *(const LAS bf16x8*)(P + (wave * 16 + fr) * P_LD + g * 64 + ks * 32 + fq * 8);
#pragma unroll
            for (int gq = 0; gq < 2; ++gq) {
                f32x4 acc2[2];
#pragma unroll
                for (int th = 0; th < 2; ++th) {
                    f32x4 acc = {0.f, 0.f, 0.f, 0.f};
#pragma unroll
                    for (int ks = 0; ks < 2; ++ks) {
                        const bf16x8 wf = *(const LAS bf16x8*)(PWt + (g * 64 + gq * 32 + th * 16 + fr) * PWT_LD + ks * 32 + fq * 8);
                        acc = __builtin_amdgcn_mfma_f32_16x16x32_bf16(wf, pf[ks], acc, 0, 0, 0);
                    }
                    acc2[th] = acc;
                }
                const int col = g * 64 + gq * 32 + 8 * fq;
                const f32x4 sc0 = *(const f32x4*)(p.pool_scale + col), sc1 = *(const f32x4*)(p.pool_scale + col + 4);
                u32x4 o; o.x = pk2(acc2[0][0] * sc0.x, acc2[0][1] * sc0.y); o.y = pk2(acc2[0][2] * sc0.z, acc2[0][3] * sc0.w);
                o.z = pk2(acc2[1][0] * sc1.x, acc2[1][1] * sc1.y); o.w = pk2(acc2[1][2] * sc1.z, acc2[1][3] * sc1.w);
                *(u32x4*)(Yb + (size_t)(wave * 16 + fr) * D + col) = o;
            }
        }
        __syncthreads();
    }
#endif
#ifndef SKIP_GATE
    for (int repb = 0; repb < REP_MIXB; ++repb) {
        const int tid = mk_tid(wave), lane = tid & 63;
        LAS bf16* VT = (LAS bf16*)(lds + MX_VT);
        LAS f32x2* LNT = (LAS f32x2*)(lds + MX_LNT);
        if (tid < W_B) LNT[tid] = (f32x2){p.sg_ln_g[tid], p.sg_ln_b[tid]};
        {
            const int t = tid >> 2, part = tid & 3;
            const bf16* zr = Zb + (size_t)t * D_IN + ZV_OFF + part * 8;
            float v[96]; float s1 = 0.f, s2 = 0.f;
#pragma unroll
            for (int i = 0; i < 12; ++i) { const u32x4 w = *(const u32x4*)(zr + 32 * i);
                const unsigned ww[4] = {w.x, w.y, w.z, w.w};
#pragma unroll
                for (int e = 0; e < 4; ++e) { const float a = gelu_tanh(bflo(ww[e])), b = gelu_tanh(bfhi(ww[e])); v[8 * i + 2 * e] = a; v[8 * i + 2 * e + 1] = b; s1 += a + b; s2 += a * a + b * b; } }
            s1 += __shfl_xor(s1, 1); s2 += __shfl_xor(s2, 1); s1 += __shfl_xor(s1, 2); s2 += __shfl_xor(s2, 2);
            const float mean = s1 * (1.f / W_B), var = s2 * (1.f / W_B) - mean * mean, rstd = fast_rsq(fmaxf(var, 0.f) + EPS);
            __syncthreads();
#pragma unroll
            for (int j = 0; j < 96; ++j) { const int c = 8 * (4 * (j >> 3) + part) + (j & 7); const f32x2 gb = LNT[c]; const float y = (v[j] - mean) * rstd * gb.x + gb.y;
                const int slot = 32 * (j >> 3) + 16 * ((j >> 2) & 1) + 4 * part + (j & 3);
                VT[slot * VT_LD + t] = (bf16)(pk2(y, 0.f) & 0xffffu); }
        }
        const int tid2 = mk_tid(wave), lane2 = tid2 & 63;
        const int fr = lane2 & 15, fq = lane2 >> 4;
        const int nks = (wave >> 1) + 1;
        const int trow = wave * 16 + fr;
        bf16x8 wf[4][4]; u32x4 uz[4][3]; float sb[4];
#pragma unroll
        for (int h = 0; h < 4; ++h) {
#pragma unroll
            for (int ks = 0; ks < 4; ++ks) wf[h][ks] = (ks < nks) ? *(const bf16x8*)(p.SGW + ((size_t)(h * 128 + trow) * 128 + ks * 32 + fq * 8)) : (bf16x8){0, 0, 0, 0, 0, 0, 0, 0};
            sb[h] = p.sg_b[h * 128 + trow];
#pragma unroll
            for (int gq = 0; gq < 3; ++gq) uz[h][gq] = *(const u32x4*)(Zb + (size_t)trow * D_IN + ZB_OFF + h * 96 + gq * 32 + 8 * fq);
        }
        __syncthreads();
#pragma unroll
        for (int h = 0; h < 4; ++h) {
#pragma unroll
            for (int gq = 0; gq < 3; ++gq) {
                f32x4 acc2[2];
#pragma unroll
                for (int th = 0; th < 2; ++th) {
                    f32x4 acc = {0.f, 0.f, 0.f, 0.f};
#pragma unroll
                    for (int ks = 0; ks < 4; ++ks) {
                        if (ks < nks) {
                            const bf16x8 vf = *(const LAS bf16x8*)(VT + (h * 96 + gq * 32 + th * 16 + fr) * VT_LD + ks * 32 + fq * 8);
                            acc = __builtin_amdgcn_mfma_f32_16x16x32_bf16(vf, wf[h][ks], acc, 0, 0, 0);
                        }
                    }
                    acc2[th] = acc;
                }
                const u32x4 uw = uz[h][gq];
                const float u0 = gelu_tanh(bflo(uw.x)), u1 = gelu_tanh(bfhi(uw.x)), u2 = gelu_tanh(bflo(uw.y)), u3 = gelu_tanh(bfhi(uw.y));
                const float u4 = gelu_tanh(bflo(uw.z)), u5 = gelu_tanh(bfhi(uw.z)), u6 = gelu_tanh(bflo(uw.w)), u7 = gelu_tanh(bfhi(uw.w));
                u32x4 o; o.x = pk2(u0 * (acc2[0][0] + sb[h]), u1 * (acc2[0][1] + sb[h])); o.y = pk2(u2 * (acc2[0][2] + sb[h]), u3 * (acc2[0][3] + sb[h]));
                o.z = pk2(u4 * (acc2[1][0] + sb[h]), u5 * (acc2[1][1] + sb[h])); o.w = pk2(u6 * (acc2[1][2] + sb[h]), u7 * (acc2[1][3] + sb[h]));
                *(u32x4*)(Yb + (size_t)trow * D + W_A + h * 96 + gq * 32 + 8 * fq) = o;
            }
        }
        __syncthreads();
    }
#endif
}

constexpr int AT_LD = 528;
#define AT_STAGE_IDX const int tids = mk_tid(wave), t5 = tids >> 5, c16 = tids & 31;
#define AT_STAGE_IDX_W(w_) const int tids = mk_tid(w_), t5 = tids >> 5, c16 = tids & 31;
#define AT_KOFF const int pe = 16 * ((t5 >> 2) & 1) + 4 * (t5 >> 3) + (t5 & 3); const unsigned voe = (unsigned)(pe * D + c16 * 8), voo = (unsigned)((pe + 8) * D + c16 * 8);
__device__ __forceinline__ void attn_unit(LAS unsigned char* lds, const bf16* Vt, bf16* O, const int wave, const int h, const int q0, const int b, u32x4 (&st)[16], const bf16x8 (&qf)[16]) {
    const int tid = mk_tid(wave), lane = tid & 63, r32 = lane & 31, hi = lane >> 5;
    const LAS unsigned char* ka = lds + r32 * AT_LD + hi * 16;
    const LAS unsigned char* va = lds + r32 * AT_LD + hi * 32;
        __syncthreads();
        { AT_STAGE_IDX LAS unsigned char* lw = lds + t5 * AT_LD + c16 * 16;
#pragma unroll
          for (int i = 0; i < 16; ++i) *(LAS u32x4*)(lw + i * 16 * AT_LD) = st[i]; }
        __syncthreads();
        f32x16 S[8];
        {
            bf16x8 kf[2][4];
#pragma unroll
            for (int j = 0; j < 4; ++j) kf[0][j] = *(const LAS bf16x8*)(ka + j * 32);
#pragma unroll
            for (int mt = 0; mt < 8; ++mt) {
                f32x16 acc;
#pragma unroll
                for (int e = 0; e < 16; ++e) acc[e] = 0.f;
#pragma unroll
                for (int k4 = 0; k4 < 4; ++k4) {
                    const int g = mt * 4 + k4, gn = g + 1;
                    if (gn < 32) {
#pragma unroll
                        for (int j = 0; j < 4; ++j) kf[gn & 1][j] = *(const LAS bf16x8*)(ka + (gn >> 2) * 32 * AT_LD + ((gn & 3) * 4 + j) * 32);
                    }
                    __builtin_amdgcn_sched_barrier(0);
#pragma unroll
                    for (int j = 0; j < 4; ++j) acc = __builtin_amdgcn_mfma_f32_32x32x16_bf16(kf[g & 1][j], qf[k4 * 4 + j], acc, 0, 0, 0);
                    __builtin_amdgcn_sched_barrier(0);
                }
                S[mt] = acc;
            }
        }
        {
            AT_STAGE_IDX const unsigned vo = (unsigned)(t5 * MMEM + c16 * 8);
            const bf16* vbase = Vt + (size_t)(h * 256) * MMEM + b * NMEM;
#pragma unroll
            for (int i = 0; i < 8; ++i) { const bf16* vb_i = vbase + (size_t)i * 16 * MMEM; st[i] = *(const u32x4*)(vb_i + vo); }
        }
        float mx = -3.0e38f;
#pragma unroll
        for (int mt = 0; mt < 8; ++mt)
#pragma unroll
            for (int e = 0; e < 16; ++e) mx = fmaxf(mx, S[mt][e]);
        mx = fmaxf(mx, __shfl_xor(mx, 32));
        float sum = 0.f;
        bf16x8 pf[8][2];
        const float mxl = mx * 1.4426950409f;
#pragma unroll
        for (int mt = 0; mt < 8; ++mt) {
#pragma unroll
            for (int e = 0; e < 16; ++e) { const float pe_ = __builtin_amdgcn_exp2f(S[mt][e] * 1.4426950409f - mxl); S[mt][e] = pe_; sum += pe_; }
#pragma unroll
            for (int hf = 0; hf < 2; ++hf) {
                u32x4 w; w.x = pk2(S[mt][8 * hf + 0], S[mt][8 * hf + 1]); w.y = pk2(S[mt][8 * hf + 2], S[mt][8 * hf + 3]);
                w.z = pk2(S[mt][8 * hf + 4], S[mt][8 * hf + 5]); w.w = pk2(S[mt][8 * hf + 6], S[mt][8 * hf + 7]);
                pf[mt][hf] = __builtin_bit_cast(bf16x8, w);
            }
        }
        sum += __shfl_xor(sum, 32);
        const float inv = fast_rcp(sum);
        __syncthreads();
        { AT_STAGE_IDX LAS unsigned char* lw = lds + t5 * AT_LD + c16 * 16;
#pragma unroll
          for (int i = 0; i < 8; ++i) *(LAS u32x4*)(lw + i * 16 * AT_LD) = st[i]; }
        {
            AT_STAGE_IDX const unsigned vo = (unsigned)(t5 * MMEM + c16 * 8);
            const bf16* vbase = Vt + (size_t)(h * 256) * MMEM + b * NMEM;
#pragma unroll
            for (int i = 8; i < 16; ++i) { const bf16* vb_i = vbase + (size_t)i * 16 * MMEM; st[i] = *(const u32x4*)(vb_i + vo); }
        }
        __syncthreads();
        bf16* op = O + (size_t)(q0 + r32) * D + h * 256;
#pragma unroll
        for (int ob = 0; ob < 2; ++ob) {
            if (ob == 1) {
                { AT_STAGE_IDX LAS unsigned char* lw = lds + t5 * AT_LD + c16 * 16;
#pragma unroll
                  for (int i = 8; i < 16; ++i) *(LAS u32x4*)(lw + i * 16 * AT_LD) = st[i]; }
                __syncthreads();
            }
            bf16x8 vf[2][4];
#pragma unroll
            for (int j = 0; j < 4; ++j) vf[0][j] = *(const LAS bf16x8*)(va + (4 * ob) * 32 * AT_LD + ((j >> 1) * 32 + 8 * (j & 1)) * 2);
#pragma unroll
            for (int dtl = 0; dtl < 4; ++dtl) {
                const int dt = 4 * ob + dtl;
                f32x16 acc;
#pragma unroll
                for (int e = 0; e < 16; ++e) acc[e] = 0.f;
#pragma unroll
                for (int q4 = 0; q4 < 4; ++q4) {
                    const int g = dtl * 4 + q4, gn = g + 1;
                    if (gn < 16) {
#pragma unroll
                        for (int j = 0; j < 4; ++j) vf[gn & 1][j] = *(const LAS bf16x8*)(va + (4 * ob + (gn >> 2)) * 32 * AT_LD + (((gn & 3) * 2 + (j >> 1)) * 32 + 8 * (j & 1)) * 2);
                    }
                    __builtin_amdgcn_sched_barrier(0);
#pragma unroll
                    for (int j = 0; j < 4; ++j) acc = __builtin_amdgcn_mfma_f32_32x32x16_bf16(vf[g & 1][j], pf[q4 * 2 + (j >> 1)][j & 1], acc, 0, 0, 0);
                    __builtin_amdgcn_sched_barrier(0);
                }
                u32x2 o[4];
#pragma unroll
                for (int j = 0; j < 4; ++j) { o[j].x = pk2(acc[4 * j] * inv, acc[4 * j + 1] * inv); o[j].y = pk2(acc[4 * j + 2] * inv, acc[4 * j + 3] * inv); }
#pragma unroll
                for (int pr = 0; pr < 2; ++pr) {
                    const auto rx = __builtin_amdgcn_permlane32_swap(o[2 * pr].x, o[2 * pr + 1].x, false, false);
                    const auto ry = __builtin_amdgcn_permlane32_swap(o[2 * pr].y, o[2 * pr + 1].y, false, false);
                    const u32x4 w = {rx[0], ry[0], rx[1], ry[1]};
                    *(u32x4*)(op + dt * 32 + 8 * (2 * pr + hi)) = w; }
            }
        }
    __syncthreads();
}

constexpr int TB_Q_OFF = 139264;
struct EpiQ {
    static constexpr bool PERM = true, AFTER_DRAIN = true;
    float scale; const bf16* Kb; const bf16* Vt; bf16* O; int pm_off; int wave0;
    __device__ __forceinline__ void fused(pg8::f32x4 (&acc)[2][2][4][2], const pg8::Unit& u, int wr, int wc, int fr, int fq, LAS unsigned char* lds, int wid, int lane) const {
        const int pmg = __builtin_amdgcn_readfirstlane(u.pm + pm_off), h = __builtin_amdgcn_readfirstlane(u.pn), b = (pmg * 256) / SEQ, q0 = pmg * 256 + wave0 * 32;
        u32x4 st[16];
        const LAS float* tb = (const LAS float*)(lds + TB_Q_OFF);
#pragma unroll
        for (int ai = 0; ai < 2; ++ai)
#pragma unroll
            for (int m = 0; m < 4; ++m) { const int row = ai * 128 + wr * 64 + m * 16 + fr; const float rsv = tb[row] * scale;
#pragma unroll
                for (int bj = 0; bj < 2; ++bj) { const pg8::f32x4 v0 = acc[ai][bj][m][0] * rsv, v1 = acc[ai][bj][m][1] * rsv;
                    u32x4 w; w.x = pk2(v0[0], v0[1]); w.y = pk2(v0[2], v0[3]); w.z = pk2(v1[0], v1[1]); w.w = pk2(v1[2], v1[3]);
                    *(LAS u32x4*)(lds + row * AT_LD + (bj * 128 + wc * 32 + 8 * fq) * 2) = w; } }
        {
            AT_STAGE_IDX_W(wave0) AT_KOFF
            const bf16* kbase = Kb + (size_t)(b * NMEM) * D + h * 256;
#pragma unroll
            for (int i = 0; i < 16; ++i) { const bf16* kb_i = kbase + (size_t)(i >> 1) * 32 * D; st[i] = *(const u32x4*)(kb_i + ((i & 1) ? voo : voe)); }
        }
        __syncthreads();
        bf16x8 qf[16];
        { const int r32 = lane & 31, hi = lane >> 5; const LAS unsigned char* qp = lds + (wave0 * 32 + r32) * AT_LD + hi * 16;
#pragma unroll
          for (int ks = 0; ks < 16; ++ks) qf[ks] = *(const LAS bf16x8*)(qp + ks * 32); }
        LDS_WAIT();
        attn_unit(lds, Vt, O, wave0, h, q0, b, st, qf);
    }
};
__device__ __forceinline__ void run_gemm_qattn(LAS unsigned char* lds, const bf16* A, const bf16* Bt, const float* rs, const bf16* Kb, const bf16* Vt, bf16* O, int G, int c, const int wave0) {
#pragma unroll 1
    for (int half = 0; half < 2; ++half) {
        const int tid = mk_tid(wave0);
        pg8::Gemm g{A + (size_t)half * (M / 2) * D, Bt, M / 2, D, D}; pg8::StaticOrder S; S.init(M / 2, D, G, c); S.wgm = WGM_Q;
        { pg8::Unit u; if (S.next(0, u) && tid < 256) { const f32x4 s4 = *(const f32x4*)(rs + 4 * (size_t)((u.pm + half * (M / 2 / 256)) * 256 + tid));
            ((LAS float*)(lds + TB_Q_OFF))[tid] = fast_rsq(((s4[0] + s4[1]) + (s4[2] + s4[3])) * (1.0f / 1024.0f) + EPS); } }
        __syncthreads();
        EpiQ E{0.0625f, Kb, Vt, O, half * (M / 2 / 256), wave0};
        pg8::gemm_phase<EpiQ, pg8::StaticOrder, false, true>(lds, g, S, E, tid);
    }
}

constexpr int TB_RS_OFF = 131072, TB_BIAS_OFF = 131072 + 8192;
__device__ __forceinline__ void run_gemm(LAS unsigned char* lds, const bf16* A, const bf16* Bt, int m, int n, int k, bf16* O, int ldc, const float* bias, const float* rs, float scale, int act, int G, int c, int tid) {
    pg8::Gemm g{A, Bt, m, n, k}; pg8::StaticOrder S; S.init(m, n, G, c); S.wgm = (n == FF) ? WGM_FF1 : ((n == D_IN) ? WGM_IN : 8);
    LAS float* tb_rs = (LAS float*)(lds + TB_RS_OFF); LAS float* tb_bias = (LAS float*)(lds + TB_BIAS_OFF);
    if (rs || bias) {
        pg8::Unit u;
        for (int i = 0; i < 8 && S.next(i, u); ++i) {
            if (tid < 256) { if (rs) { const f32x4 s4 = *(const f32x4*)(rs + 4 * (size_t)(u.pm * 256 + tid)); tb_rs[i * 256 + tid] = fast_rsq(((s4[0] + s4[1]) + (s4[2] + s4[3])) * (1.0f / 1024.0f) + EPS); } }
            else if (bias && i < 4) tb_bias[i * 256 + (tid - 256)] = bias[u.pn * 256 + (tid - 256)];
        }
        __syncthreads();
    }
    pg8::EpiGen E{O, ldc, bias ? tb_bias : nullptr, rs ? tb_rs : nullptr, scale, act, 0};
    pg8::gemm_phase<pg8::EpiGen, pg8::StaticOrder, true, true>(lds, g, S, E, tid);
}

__device__ __forceinline__ void run_gemm_fused(LAS unsigned char* lds, const bf16* A, const bf16* Bt, int k, bf16* XB, float* outf, const float* g1, float* SS2, unsigned* xbuf, unsigned* cnt, int G, int c, const int wave0) {
#pragma unroll 1
    for (int half = 0; half < 2; ++half) {
        const int tid = mk_tid(wave0);
        pg8::Gemm g{A + (size_t)half * (M / 2) * k, Bt, M / 2, D, k}; pg8::StaticOrder S; S.init(M / 2, D, G, c); S.wgm = WGM_FZ;
        pg8::EpiResNorm E{XB, outf, g1, SS2, half * (M / 2 / 256), xbuf, cnt};
        pg8::gemm_phase<pg8::EpiResNorm, pg8::StaticOrder, false, true>(lds, g, S, E, tid);
    }
}

__global__ void __launch_bounds__(NTHREADS, 2) fwd_megakernel(Args a) {
    extern __shared__ __attribute__((aligned(16))) unsigned char lds_raw[];
    LAS unsigned char* lds = (LAS unsigned char*)lds_raw;
    cg::grid_group grid = cg::this_grid();
    if (a.ph_lo < 0) grid.sync();
    const int wave0 = __builtin_amdgcn_readfirstlane(threadIdx.x >> 6);
    { LAS unsigned* misc = (LAS unsigned*)(lds + MISC_OFF); const int t_ = mk_tid(wave0); if (t_ < 16) misc[t_] = 0u; }
    __syncthreads();
    const XcdBarrier xbar = xcd_barrier_post((unsigned*)(a.ws + WS_CTL) + CW_BAR, (volatile LAS unsigned*)(lds + MISC_OFF) + 8, mk_tid(wave0) == 0);
    const AS4 unsigned char* kargs = (const AS4 unsigned char*)__builtin_amdgcn_kernarg_segment_ptr();
    const int G = gridDim.x, bx = blockIdx.x;
    const int NGW = G * NWAVES;
    unsigned char* ws = a.ws;
    bf16* XN = (bf16*)(ws + WS_XN); bf16* Y = (bf16*)(ws + WS_Y); bf16* Z = (bf16*)(ws + WS_Z); bf16* BUFA = (bf16*)(ws + WS_BUFA); bf16* F = (bf16*)(ws + WS_F); float* RS = (float*)(ws + WS_RS);

#pragma unroll 1
    for (int ph = a.ph_lo; ph < a.ph_hi; ++ph) {
        if (ph > a.ph_lo) { for (int rep = 0; rep < REP_SYNC; ++rep) { xcd_barrier(xbar, mk_tid(wave0) == 0); } }
        int kz = 0; asm volatile("" : "+s"(kz));
        const int tid = mk_tid(wave0);
        const int lane = tid & 63, wave = wave0;
        const int gw = bx * NWAVES + wave;
        if (ph == 0) { for (int rep = 0; rep < REP_P0; ++rep) { p0_prologue(kargs, kz, ws, lds, gw, NGW, wave, lane); __syncthreads(); } continue; }
        bool is_gemm = false;
        const bf16* gA = nullptr; const bf16* gB = nullptr; int gm = 0, gn = 0, gk = 0; bf16* gO = nullptr; int gld = 0; const float* gbias = nullptr; const float* grs = nullptr; float gscale = 1.f; int gact = 0, gG = G, gc = bx;
        const int l = (ph - 1) / 7, sub = (ph - 1) % 7;
        const unsigned char* wb = ws + WS_W + (size_t)l * WS_WL;
        const float* fz_g = nullptr; int fz_bank = 0; float* fz_out = nullptr;
        switch (sub) {
        case 0: is_gemm = true; gA = XN; gB = (const bf16*)(wb + WO_IN); gm = M; gn = D_IN; gk = D; gO = Z; gld = D_IN; gbias = KIN(4) + (size_t)l * D_IN; grs = RS; break;
        case 1: {
            MixP p; p.Z = Z; p.YC = BUFA; p.pool_w = KIN(5) + (size_t)l * 4 * 64 * 64; p.pool_scale = KIN(6) + (size_t)l * W_A;
            p.sg_ln_g = KIN(7) + (size_t)l * W_B; p.sg_ln_b = KIN(8) + (size_t)l * W_B; p.sg_b = KIN(10) + (size_t)l * 4 * 128;
            p.conv_w = KIN(11) + (size_t)l * CONV_K * W_C; p.conv_b = KIN(12) + (size_t)l * W_C; p.conv_ln_g = KIN(13) + (size_t)l * W_C; p.conv_ln_b = KIN(14) + (size_t)l * W_C;
            p.SGW = (const bf16*)(ws + WS_SGW) + (size_t)l * 4 * 128 * 128;
            for (int rep = 0; rep < REP_MIX; ++rep) for (int u = bx; u < M / 128; u += G) mixer_unit(lds, p, u, wave0);
        } break;
        case 2: gA = BUFA; gB = (const bf16*)(wb + WO_OUT); gk = D; fz_g = KIN(16) + (size_t)l * D; fz_bank = l * 3 + 0; break;
        case 3: run_gemm_qattn(lds, XN, (const bf16*)(wb + WO_Q), RS, (const bf16*)(ws + WS_KB + (size_t)l * MiB), (const bf16*)(ws + WS_VT + (size_t)l * MiB), Z, G, bx, wave0); break;
        case 4: gA = Z; gB = (const bf16*)(wb + WO_O); gk = D; fz_g = KIN(23) + (size_t)l * D; fz_bank = l * 3 + 1; break;
        case 5: is_gemm = true; gA = XN; gB = (const bf16*)(wb + WO_1); gm = M; gn = FF; gk = D; gO = F; gld = FF; gact = 1; grs = RS; break;
        case 6: gA = F; gB = (const bf16*)(wb + WO_2); gk = FF; fz_g = KIN(27) + (size_t)l * D; fz_bank = l * 3 + 2; fz_out = (l + 1 < DEPTH) ? nullptr : KOUT; break;
        default: break;
        }
        if (fz_g) run_gemm_fused(lds, gA, gB, gk, XN, fz_out, fz_g, RS, (unsigned*)(ws + WS_XBUF) + (size_t)fz_bank * M * 4, (unsigned*)(ws + WS_CTL) + CW_SEAM + fz_bank * SEAM_BANK, G, bx, wave0);
#ifndef SKIP_GEMM
        const int npass = (ph == 1) ? 2 : 1;
#pragma unroll 1
        for (int pass = 0; pass < npass; ++pass) {
            if (pass == 1) {
                const int cb = bx - (G >= 256 ? 128 : 0);
                const int gi = (cb >> 3) & 3, kl = gi >> 1, isv = gi & 1;
                const bf16* mn = (const bf16*)(ws + WS_MN + (size_t)kl * MiB);
                const unsigned char* kwb = ws + WS_W + (size_t)kl * WS_WL;
                gk = D; gG = 8; gc = (cb >= 0 && cb < 32) ? (cb & 7) : (1 << 24); gbias = nullptr; grs = nullptr; gscale = 1.f; gact = 0;
                if (isv) { gA = (const bf16*)(kwb + WO_V); gB = mn; gm = D; gn = MMEM; gO = (bf16*)(ws + WS_VT + (size_t)kl * MiB); gld = MMEM; }
                else     { gA = mn; gB = (const bf16*)(kwb + WO_K); gm = MMEM; gn = D; gO = (bf16*)(ws + WS_KB + (size_t)kl * MiB); gld = D; }
            }
            if (is_gemm) for (int rep = 0; rep < REP_GEMM; ++rep) run_gemm(lds, gA, gB, gm, gn, gk, gO, gld, gbias, grs, gscale, gact, gG, gc, mk_tid(wave0));
        }
#endif
    }
}

extern "C" void kernel_launch(void* const* d_in, const int* in_sizes, int n_in, void* d_out, int out_size, void* d_ws, size_t ws_size, hipStream_t stream) {
    static int grid = 0;
    if (grid == 0) {
        if (n_in != 28 || in_sizes[0] != M * D || out_size != M * D || ws_size < WS_END) { fprintf(stderr, "kernel_launch: unexpected shapes (n_in %d, in0 %d, out %d, ws %zu)\n", n_in, n_in > 0 ? in_sizes[0] : -1, out_size, ws_size); grid = -1; return; }
        int dev = 0, cus = 0, per_cu = 0;
        hipGetDevice(&dev);
        hipDeviceGetAttribute(&cus, hipDeviceAttributeMultiprocessorCount, dev);
        if (hipFuncSetAttribute((const void*)fwd_megakernel, hipFuncAttributeMaxDynamicSharedMemorySize, LDS_BYTES) != hipSuccess) { fprintf(stderr, "kernel_launch: hipFuncSetAttribute failed\n"); grid = -1; return; }
        if (hipOccupancyMaxActiveBlocksPerMultiprocessor(&per_cu, (const void*)fwd_megakernel, NTHREADS, LDS_BYTES) != hipSuccess || per_cu < 1) { fprintf(stderr, "kernel_launch: occupancy query says %d\n", per_cu); per_cu = 1; }
        (void)hipGetLastError();
        grid = cus * 1;
        if (grid != 256) fprintf(stderr, "kernel_launch: %d workgroups; the fused residual+norm epilogues need exactly 256 (one 256x256 unit per workgroup)\n", grid);
        fprintf(stderr, "kernel_launch: grid %d (cus %d, per_cu %d)\n", grid, cus, per_cu);
    }
    if (grid < 0) return;
    Args a{};
    for (int i = 0; i < 28; ++i) a.in[i] = (const float*)d_in[i];
    a.out = (float*)d_out; a.ws = (unsigned char*)d_ws;
#if MK_N_LAUNCHES == 1
    if (hipMemsetAsync((char*)d_ws + WS_CTL, 0, CTL_ZERO_BYTES, stream) != hipSuccess) { fprintf(stderr, "kernel_launch: memset failed\n"); return; }
    a.ph_lo = 0; a.ph_hi = NPH;
    void* args[] = {&a};
    hipError_t e = hipLaunchCooperativeKernel((const void*)fwd_megakernel, dim3(grid), dim3(NTHREADS), args, LDS_BYTES, stream);
    if (e != hipSuccess) fprintf(stderr, "kernel_launch: cooperative launch failed: %s (grid %d)\n", hipGetErrorString(e), grid);
#else
    for (int ph = 0; ph < NPH; ++ph) {
        a.ph_lo = ph; a.ph_hi = ph + 1;
        hipLaunchKernelGGL(fwd_megakernel, dim3(grid), dim3(NTHREADS), LDS_BYTES, stream, a);
    }
#endif
}
```
